# Optimizing an MI355X kernel written in HIP

```python
import math
import jax
import jax.numpy as jnp
from jax import lax
import numpy as np

D_MODEL = 2048
BATCH = 1
SEQ = 8192
DEPTH = 2

GRID_W = 64
CTX_LEN = 256
EPS = 1e-6
F32 = jnp.float32

GROUP_W = D_MODEL // 4
MIX_W = 4 * GROUP_W
RET_HEADS = 4
RET_DIM = GROUP_W // RET_HEADS
RET_CHUNK = 128
RET_COLS = 5 * GROUP_W
S5_CH = GROUP_W
S5_GROUP = 16
S5_NG = S5_CH // S5_GROUP
S5_P = 64
S5_COLS = GROUP_W
ATT_HEADS = 4
ATT_KV_HEADS = 2
ATT_DIM = GROUP_W // ATT_HEADS
ATT_COLS = (ATT_HEADS + 2 * ATT_KV_HEADS) * ATT_DIM
Q_BLOCK = 128
ROPE_THETA = 10000.0
CONV_CH = GROUP_W
CONV_W = 3
CONV_COLS = 3 * GROUP_W
IN_COLS = RET_COLS + S5_COLS + ATT_COLS + CONV_COLS
N_EXPERTS = 32
TOP_K = 4
D_EXPERT = D_MODEL // 2
SWIGLU_LIMIT = 7.0
SWIGLU_ALPHA = 1.702
MOE_BLOCK = 128

kernel_name = 'hybrid_parallel_group_flow_block'


def rms_norm(x):
    xf = x.astype(F32)
    return (xf * lax.rsqrt(jnp.mean(xf * xf, -1, keepdims=True) + EPS)).astype(x.dtype)


def modulate(x, shift, scale):
    return rms_norm(x) * (1.0 + scale) + shift


def head_rms(x, w):
    xf = x.astype(F32)
    return xf * lax.rsqrt(jnp.mean(xf * xf, -1, keepdims=True) + EPS) * w.astype(F32)


def group_norm(y):
    yc = y - jnp.mean(y, -1, keepdims=True)
    return yc * lax.rsqrt(jnp.mean(yc * yc, -1, keepdims=True) + EPS)


def rope_angles(pos, dim):
    freqs = ROPE_THETA ** (-jnp.arange(0, dim, 2, dtype=F32) / dim)
    return pos.astype(F32)[:, None] * freqs[None, :]


def apply_rope(x, ang):
    cos = jnp.cos(ang)[None, :, None, :]
    sin = jnp.sin(ang)[None, :, None, :]
    x1, x2 = jnp.split(x, 2, axis=-1)
    return jnp.concatenate([x1 * cos - x2 * sin, x1 * sin + x2 * cos], axis=-1)


def apply_axial_rope(x, rows, cols):
    half = x.shape[-1] // 2
    xr, xc = jnp.split(x, 2, axis=-1)
    return jnp.concatenate([apply_rope(xr, rope_angles(rows, half)),
                            apply_rope(xc, rope_angles(cols, half))], axis=-1)


def retention_chunkwise(q, k, v, log_g, s0, with_output):
    bsz, t, h, dk = q.shape
    dv = v.shape[-1]
    n = t // RET_CHUNK
    qc = q.reshape(bsz, n, RET_CHUNK, h, dk)
    kc = k.reshape(bsz, n, RET_CHUNK, h, dk)
    vc = v.reshape(bsz, n, RET_CHUNK, h, dv)
    idx = jnp.arange(RET_CHUNK, dtype=F32)
    zeta = jnp.exp((RET_CHUNK - 1.0 - idx)[:, None] * log_g[None, :])
    kv = jnp.einsum('bnjhd,bnjhe->bnhde', kc * zeta[None, None, :, :, None], vc)
    g_chunk = jnp.exp(RET_CHUNK * log_g)[None, :, None, None]

    def step(s, kv_i):
        return s * g_chunk + kv_i, (s if with_output else None)

    s_final, s_prev = lax.scan(step, s0, jnp.moveaxis(kv, 1, 0))
    if not with_output:
        return None, s_final
    s_prev = jnp.moveaxis(s_prev, 0, 1)
    diff = idx[:, None] - idx[None, :]
    decay = jnp.where(diff >= 0, jnp.exp(jnp.maximum(diff, 0.0)[None] * log_g[:, None, None]), 0.0)
    scores = jnp.einsum('bnihd,bnjhd->bnhij', qc, kc) * decay[None, None]
    xi = jnp.exp((idx + 1.0)[:, None] * log_g[None, :])
    y = (jnp.einsum('bnhij,bnjhe->bnihe', scores, vc)
         + jnp.einsum('bnihd,bnhde->bnihe', qc, s_prev) * xi[None, None, :, :, None])
    return y.reshape(bsz, t, h, dv), s_final


def retention_mixer(z_lat, z_ctx, pos_lat, ctx_out):
    def heads(z):
        q, k, v, gf, gb = jnp.split(z.astype(F32), 5, axis=-1)
        hd = lambda a: a.reshape(a.shape[0], a.shape[1], RET_HEADS, RET_DIM)
        return hd(q), hd(k) * RET_DIM ** -0.5, hd(v), gf, gb

    ql, kl, vl, gfl, gbl = heads(z_lat)
    qc, kc, vc, gfc, gbc = heads(z_ctx)
    ang = rope_angles(pos_lat, RET_DIM)
    ql, kl = apply_rope(ql, ang), apply_rope(kl, ang)
    log_g = jnp.log(1.0 - 2.0 ** (-5.0 - jnp.arange(RET_HEADS, dtype=F32)))
    s0 = jnp.zeros((z_lat.shape[0], RET_HEADS, RET_DIM, RET_DIM), F32)
    y_lat, y_ctx = [], []
    for dr, lg in enumerate((log_g, log_g[::-1])):
        flip = (lambda a: a[:, ::-1]) if dr == 1 else (lambda a: a)
        yc, s_ctx = retention_chunkwise(flip(qc), flip(kc), flip(vc), lg, s0, ctx_out)
        yl, _ = retention_chunkwise(flip(ql), flip(kl), flip(vl), lg, s_ctx, True)
        y_lat.append(group_norm(flip(yl)).reshape(z_lat.shape[0], z_lat.shape[1], GROUP_W))
        if ctx_out:
            y_ctx.append(group_norm(flip(yc)).reshape(z_ctx.shape[0], z_ctx.shape[1], GROUP_W))
    out_lat = jax.nn.silu(gfl) * y_lat[0] + jax.nn.silu(gbl) * y_lat[1]
    out_ctx = (jax.nn.silu(gfc) * y_ctx[0] + jax.nn.silu(gbc) * y_ctx[1]).astype(z_ctx.dtype) if ctx_out else None
    return out_lat.astype(z_lat.dtype), out_ctx


def s5_discretize(a_re, a_im, log_step):
    a_re = a_re.astype(F32)
    a_im = a_im.astype(F32)
    step = jnp.exp(log_step.astype(F32))[:, None]
    mag = jnp.exp(a_re * step)
    ab_re = mag * jnp.cos(a_im * step)
    ab_im = mag * jnp.sin(a_im * step)
    den = a_re * a_re + a_im * a_im
    num_re = ab_re - 1.0
    f_re = (num_re * a_re + ab_im * a_im) / den
    f_im = (ab_im * a_re - num_re * a_im) / den
    return ab_re, ab_im, f_re, f_im


def s5_scan(drive_re, drive_im, ab_re, ab_im, s0_re, s0_im):
    drive_re = drive_re.at[:, 0].add(ab_re * s0_re - ab_im * s0_im)
    drive_im = drive_im.at[:, 0].add(ab_re * s0_im + ab_im * s0_re)
    a_re = jnp.broadcast_to(ab_re, drive_re.shape)
    a_im = jnp.broadcast_to(ab_im, drive_im.shape)

    def combine(e1, e2):
        a1r, a1i, b1r, b1i = e1
        a2r, a2i, b2r, b2i = e2
        return (a2r * a1r - a2i * a1i, a2r * a1i + a2i * a1r,
                a2r * b1r - a2i * b1i + b2r, a2r * b1i + a2i * b1r + b2i)

    _, _, x_re, x_im = lax.associative_scan(combine, (a_re, a_im, drive_re, drive_im), axis=1)
    return x_re, x_im


def s5_mixer(u_lat, u_ctx, a_re, a_im, log_step, b_re, b_im, c_re, c_im, d_skip, w_glu, b_glu, ctx_out):
    def drive_in(u):
        uf = u.astype(F32).reshape(u.shape[0], u.shape[1], S5_NG, S5_GROUP)
        return (uf, jnp.einsum('btgc,gpc->btgp', uf, b_re.astype(F32)),
                jnp.einsum('btgc,gpc->btgp', uf, b_im.astype(F32)))

    ul, bl_re, bl_im = drive_in(u_lat)
    uc, bc_re, bc_im = drive_in(u_ctx)
    zero = jnp.zeros((u_lat.shape[0], S5_NG, S5_P), F32)
    lat_states, ctx_states = [], []
    for dr in range(2):
        ab_re, ab_im, f_re, f_im = s5_discretize(a_re[dr], a_im[dr], log_step[dr])
        flip = (lambda a: a[:, ::-1]) if dr == 1 else (lambda a: a)
        cr, ci = s5_scan(flip(f_re * bc_re - f_im * bc_im), flip(f_re * bc_im + f_im * bc_re),
                         ab_re, ab_im, zero, zero)
        lr, li = s5_scan(flip(f_re * bl_re - f_im * bl_im), flip(f_re * bl_im + f_im * bl_re),
                         ab_re, ab_im, cr[:, -1], ci[:, -1])
        lat_states.append((flip(lr), flip(li)))
        if ctx_out:
            ctx_states.append((flip(cr), flip(ci)))

    def readout(uf, states):
        bsz, t = uf.shape[:2]
        x_re = states[0][0] + states[1][0]
        x_im = states[0][1] + states[1][1]
        y = (jnp.einsum('btgp,gcp->btgc', x_re, c_re.astype(F32))
             - jnp.einsum('btgp,gcp->btgc', x_im, c_im.astype(F32))
             + uf * d_skip.astype(F32).reshape(S5_NG, S5_GROUP))
        y = jax.nn.gelu(y.reshape(bsz, t, S5_CH))
        return y * jax.nn.sigmoid(y @ w_glu.astype(F32) + b_glu.astype(F32))

    out_lat = readout(ul, lat_states).astype(u_lat.dtype)
    out_ctx = readout(uc, ctx_states).astype(u_ctx.dtype) if ctx_out else None
    return out_lat, out_ctx


def attend_blocks(q, k, v):
    bsz, t = q.shape[:2]
    grp = ATT_HEADS // ATT_KV_HEADS
    nb = t // Q_BLOCK
    qb = jnp.moveaxis(q.reshape(bsz, nb, Q_BLOCK, ATT_KV_HEADS, grp, ATT_DIM), 1, 0)
    scale = ATT_DIM ** -0.5

    def one_block(qi):
        s = jnp.einsum('bqkgd,bskd->bkgqs', qi, k) * scale
        p = jax.nn.softmax(s, axis=-1)
        return jnp.einsum('bkgqs,bskd->bqkgd', p, v)

    o = lax.map(one_block, qb)
    return jnp.moveaxis(o, 0, 1).reshape(bsz, t, ATT_HEADS * ATT_DIM)


def attention_mixer(z_lat, z_ctx, q_norm_w, k_norm_w, rows, cols, ctx_out):
    def qkv(z):
        bsz, t = z.shape[:2]
        q, k, v = jnp.split(z, [ATT_HEADS * ATT_DIM, (ATT_HEADS + ATT_KV_HEADS) * ATT_DIM], axis=-1)
        q = head_rms(q.reshape(bsz, t, ATT_HEADS, ATT_DIM), q_norm_w)
        k = head_rms(k.reshape(bsz, t, ATT_KV_HEADS, ATT_DIM), k_norm_w)
        return q, k, v.astype(F32).reshape(bsz, t, ATT_KV_HEADS, ATT_DIM)

    ql, kl, vl = qkv(z_lat)
    qc, kc, vc = qkv(z_ctx)
    ql = apply_axial_rope(ql, rows, cols)
    kl = apply_axial_rope(kl, rows, cols)
    out_lat = attend_blocks(ql, jnp.concatenate([kc, kl], axis=1), jnp.concatenate([vc, vl], axis=1))
    out_ctx = attend_blocks(qc, kc, vc).astype(z_ctx.dtype) if ctx_out else None
    return out_lat.astype(z_lat.dtype), out_ctx


def depthwise_conv(h, w):
    return lax.conv_general_dilated(h, w[:, None, :].astype(h.dtype), window_strides=(1,),
                                    padding=[(CONV_W // 2, CONV_W // 2)],
                                    dimension_numbers=('NWC', 'WIO', 'NWC'),
                                    feature_group_count=h.shape[-1])


def conv_mixer(z_lat, z_ctx, conv_w, ctx_out):
    def run(z):
        b_gate, c_gate, h = jnp.split(z, 3, axis=-1)
        return b_gate * depthwise_conv(c_gate * h, conv_w)

    return run(z_lat), (run(z_ctx) if ctx_out else None)


def moe_ffn(h, w_router, b_router, w_gate_up, b_gate_up, w_down, b_down):
    n_tok, d = h.shape
    logits = (h @ w_router + b_router).astype(F32)
    top_v, top_i = lax.top_k(logits, TOP_K)
    gates = jax.nn.softmax(top_v, axis=-1)
    flat_e = top_i.reshape(-1)
    flat_tok = jnp.repeat(jnp.arange(n_tok, dtype=jnp.int32), TOP_K)
    flat_g = gates.reshape(-1)
    order = jnp.argsort(flat_e)
    sorted_e = flat_e[order]
    counts = jnp.bincount(flat_e, length=N_EXPERTS)
    padded = (counts + MOE_BLOCK - 1) // MOE_BLOCK * MOE_BLOCK
    start = jnp.cumsum(counts) - counts
    pend = jnp.cumsum(padded)
    pstart = pend - padded
    dest = pstart[sorted_e] + jnp.arange(n_tok * TOP_K, dtype=jnp.int32) - start[sorted_e]
    n_blocks = -(-(n_tok * TOP_K + N_EXPERTS * (MOE_BLOCK - 1)) // MOE_BLOCK)
    n_slots = n_blocks * MOE_BLOCK
    slot_tok = jnp.full((n_slots,), n_tok, jnp.int32).at[dest].set(flat_tok[order])
    slot_g = jnp.zeros((n_slots,), F32).at[dest].set(flat_g[order])
    block_e = jnp.minimum(jnp.searchsorted(pend, jnp.arange(n_blocks) * MOE_BLOCK, side='right'),
                          N_EXPERTS - 1)
    h_pad = jnp.concatenate([h, jnp.zeros((1, d), h.dtype)], axis=0)
    xb = h_pad[slot_tok].reshape(n_blocks, MOE_BLOCK, d)

    def expert_block(args):
        xi, e = args
        gu = xi @ w_gate_up[e] + b_gate_up[e]
        gate = jnp.minimum(gu[:, 0::2], SWIGLU_LIMIT)
        up = jnp.clip(gu[:, 1::2], -SWIGLU_LIMIT, SWIGLU_LIMIT)
        act = (up + 1.0) * gate * jax.nn.sigmoid(gate * SWIGLU_ALPHA)
        return act @ w_down[e] + b_down[e]

    yb = lax.map(expert_block, (xb, block_e)).reshape(n_slots, d)
    y = jnp.zeros((n_tok + 1, d), F32).at[slot_tok].add(yb.astype(F32) * slot_g[:, None])
    return y[:n_tok].astype(h.dtype)


def setup_inputs(seed: int = 0) -> dict:
    key = jax.random.key(seed)
    ks = jax.random.split(key, 28)
    nrm = lambda k, shape, s: jax.random.normal(k, shape, F32) * s
    D, L = D_MODEL, DEPTH
    return {
        'x': nrm(ks[0], (BATCH, SEQ, D), 1.0),
        'c': nrm(ks[1], (BATCH, D), 1.0),
        'ctx': nrm(ks[2], (BATCH, CTX_LEN, D), 1.0),
        'c_ctx': nrm(ks[3], (D,), 1.0),
        'w_mod': nrm(ks[4], (L, D, 6 * D), 0.5 * D ** -0.5),
        'b_mod': nrm(ks[5], (L, 6 * D), 0.01),
        'w_in': nrm(ks[6], (L, D, IN_COLS), D ** -0.5),
        'w_out': nrm(ks[7], (L, MIX_W, D), MIX_W ** -0.5),
        's5_a_re': -0.5 + nrm(ks[8], (L, 2, S5_NG, S5_P), 0.01),
        's5_a_im': math.pi * jnp.arange(S5_P, dtype=F32) + nrm(ks[9], (L, 2, S5_NG, S5_P), 0.01),
        's5_log_step': jax.random.uniform(ks[10], (L, 2, S5_NG), F32, math.log(1e-3), math.log(1e-1)),
        's5_b_re': nrm(ks[11], (L, S5_NG, S5_P, S5_GROUP), (2 * S5_GROUP) ** -0.5),
        's5_b_im': nrm(ks[12], (L, S5_NG, S5_P, S5_GROUP), (2 * S5_GROUP) ** -0.5),
        's5_c_re': nrm(ks[13], (L, S5_NG, S5_GROUP, S5_P), (2 * S5_P) ** -0.5),
        's5_c_im': nrm(ks[14], (L, S5_NG, S5_GROUP, S5_P), (2 * S5_P) ** -0.5),
        's5_d': nrm(ks[15], (L, S5_CH), 1.0),
        's5_w_glu': nrm(ks[16], (L, S5_CH, S5_CH), S5_CH ** -0.5),
        's5_b_glu': nrm(ks[17], (L, S5_CH), 0.01),
        'q_norm_w': 1.0 + nrm(ks[18], (L, ATT_DIM), 0.01),
        'k_norm_w': 1.0 + nrm(ks[19], (L, ATT_DIM), 0.01),
        'conv_w': nrm(ks[20], (L, CONV_W, CONV_CH), CONV_W ** -0.5),
        'w_router': nrm(ks[21], (L, D, N_EXPERTS), D ** -0.5),
        'b_router': nrm(ks[22], (L, N_EXPERTS), 0.01),
        'w_gate_up': nrm(ks[23], (L, N_EXPERTS, D, 2 * D_EXPERT), D ** -0.5),
        'b_gate_up': nrm(ks[24], (L, N_EXPERTS, 2 * D_EXPERT), 0.01),
        'w_down': nrm(ks[25], (L, N_EXPERTS, D_EXPERT, D), D_EXPERT ** -0.5),
        'b_down': nrm(ks[26], (L, N_EXPERTS, D), 0.01),
    }


def reference(x, c, ctx, c_ctx, w_mod, b_mod, w_in, w_out, s5_a_re, s5_a_im, s5_log_step,
              s5_b_re, s5_b_im, s5_c_re, s5_c_im, s5_d, s5_w_glu, s5_b_glu, q_norm_w, k_norm_w,
              conv_w, w_router, b_router, w_gate_up, b_gate_up, w_down, b_down):
    bsz, seq_len, d = x.shape
    ctx_len = ctx.shape[1]
    n_rows = seq_len // GRID_W
    pos = jnp.arange(seq_len, dtype=jnp.int32)
    rows = jnp.repeat(jnp.arange(n_rows, dtype=jnp.int32), GRID_W, total_repeat_length=seq_len)
    cols = pos % GRID_W
    act_c = jax.nn.silu(c)[:, None, :]
    act_cc = jax.nn.silu(c_ctx)[None, None, :]
    splits = [RET_COLS, RET_COLS + S5_COLS, RET_COLS + S5_COLS + ATT_COLS]
    x_lat, x_ctx = x, ctx
    for l in range(DEPTH):
        ctx_out = l < DEPTH - 1
        sh1, sc1, g1, sh2, sc2, g2 = jnp.split(act_c @ w_mod[l] + b_mod[l], 6, axis=-1)
        csh1, csc1, cg1, csh2, csc2, cg2 = jnp.split(act_cc @ w_mod[l] + b_mod[l], 6, axis=-1)
        z_lat = modulate(x_lat, sh1, sc1) @ w_in[l]
        z_ctx = modulate(x_ctx, csh1, csc1) @ w_in[l]
        zr_l, zs_l, za_l, zc_l = jnp.split(z_lat, splits, axis=-1)
        zr_c, zs_c, za_c, zc_c = jnp.split(z_ctx, splits, axis=-1)
        r_l, r_c = retention_mixer(zr_l, zr_c, pos, ctx_out)
        s_l, s_c = s5_mixer(zs_l, zs_c, s5_a_re[l], s5_a_im[l], s5_log_step[l], s5_b_re[l], s5_b_im[l],
                            s5_c_re[l], s5_c_im[l], s5_d[l], s5_w_glu[l], s5_b_glu[l], ctx_out)
        a_l, a_c = attention_mixer(za_l, za_c, q_norm_w[l], k_norm_w[l], rows, cols, ctx_out)
        v_l, v_c = conv_mixer(zc_l, zc_c, conv_w[l], ctx_out)
        x_lat = x_lat + g1 * (jnp.concatenate([r_l, s_l, a_l, v_l], axis=-1) @ w_out[l])
        f_lat = modulate(x_lat, sh2, sc2)
        if ctx_out:
            x_ctx = x_ctx + cg1 * (jnp.concatenate([r_c, s_c, a_c, v_c], axis=-1) @ w_out[l])
            f_ctx = modulate(x_ctx, csh2, csc2)
            tok = jnp.concatenate([f_ctx, f_lat], axis=1).reshape(-1, d)
            out = moe_ffn(tok, w_router[l], b_router[l], w_gate_up[l], b_gate_up[l],
                          w_down[l], b_down[l]).reshape(bsz, ctx_len + seq_len, d)
            x_ctx = x_ctx + cg2 * out[:, :ctx_len]
            x_lat = x_lat + g2 * out[:, ctx_len:]
        else:
            out = moe_ffn(f_lat.reshape(-1, d), w_router[l], b_router[l], w_gate_up[l], b_gate_up[l],
                          w_down[l], b_down[l]).reshape(bsz, seq_len, d)
            x_lat = x_lat + g2 * out
    return x_lat
```

```cpp
#include <hip/hip_runtime.h>
#include <cstdio>
#include <cstdint>

#ifndef MK_MULTI
#define MK_MULTI 0
#endif

#define LAS __attribute__((address_space(3)))
typedef unsigned short bf16_t;
typedef short bf16x8 __attribute__((ext_vector_type(8)));
typedef short s16x4 __attribute__((ext_vector_type(4)));
typedef float f32x4 __attribute__((ext_vector_type(4)));
typedef float f32x2 __attribute__((ext_vector_type(2)));
typedef float f32x16 __attribute__((ext_vector_type(16)));
typedef unsigned u32x4 __attribute__((ext_vector_type(4)));
typedef unsigned u32x2 __attribute__((ext_vector_type(2)));

constexpr int D = 2048, SEQ = 8192, CTXL = 256, ROWS = SEQ + CTXL, INC = 5632, NL = 2;
constexpr int ZC_RQ = 0, ZC_RK = 512, ZC_RV = 1024, ZC_GF = 1536, ZC_GB = 2048, ZC_U = 2560, ZC_AQ = 3072, ZC_AK = 3584, ZC_AV = 3840, ZC_CB = 4096, ZC_CC = 4608, ZC_CH = 5120;
constexpr int NE = 32, DE = 1024;
constexpr int NBLK = ROWS / 128;
constexpr int NCH = ROWS / 32;
constexpr int HROWS = 42240;
constexpr float EPS = 1e-6f;
constexpr float LOG2_1E4 = 13.287712379549449f;
constexpr int NPH = 3 + 10 * NL;

constexpr size_t al256(size_t x) { return (x + 255) / 256 * 256; }
constexpr size_t WS_CTL = 0, CTL_BYTES = 65536;
constexpr int CW_BAR = 0, CW_CNT = 10240, CW_Q8 = 9344, CW_QB = 9408, CW_PG = 9472;
constexpr size_t WS_MODP = al256(WS_CTL + CTL_BYTES);
constexpr size_t WS_MOD = al256(WS_MODP + (size_t)32 * 2 * 2 * 12288 * 4);
constexpr size_t WS_WIN = al256(WS_MOD + (size_t)2 * 2 * 12288 * 4);
constexpr size_t WS_WOUT = al256(WS_WIN + (size_t)2 * INC * D * 2);
constexpr size_t WS_WGLU = al256(WS_WOUT + (size_t)2 * D * D * 2);
constexpr size_t WS_WGU = al256(WS_WGLU + (size_t)2 * 512 * 512 * 2);
constexpr size_t WS_WDN = al256(WS_WGU + (size_t)2 * NE * 2048 * 2048 * 2);
constexpr size_t WS_WRT = al256(WS_WDN + (size_t)2 * NE * 2048 * 1024 * 2);
constexpr size_t WS_KTAB = al256(WS_WRT + (size_t)2 * 2 * 32 * 2048 * 2);
constexpr size_t WS_WE = al256(WS_KTAB + (size_t)2 * 32 * 2 * 32 * 256 * 4);
constexpr size_t WS_WTC = al256(WS_WE + (size_t)2 * 32 * 256 * 512 * 2);
constexpr size_t WS_APOW = al256(WS_WTC + (size_t)2 * 32 * 512 * 768 * 2);
constexpr size_t WS_XN = al256(WS_APOW + (size_t)2 * 32 * 2 * 64 * 2 * 4);
constexpr size_t WS_Z = al256(WS_XN + (size_t)ROWS * D * 2);
constexpr size_t WS_UPX = al256(WS_Z + (size_t)ROWS * INC * 2);
constexpr size_t WS_E = al256(WS_UPX + (size_t)32 * 512 * 768 * 2);
constexpr size_t WS_KVT = al256(WS_E + (size_t)32 * 512 * 256 * 4);
constexpr size_t WS_SPREV = al256(WS_KVT + (size_t)NBLK * 8 * 16384 * 4);
constexpr size_t WS_OP = al256(WS_SPREV + (size_t)NBLK * 8 * 16384 * 2);
constexpr size_t WS_ML = al256(WS_OP + (size_t)2 * ROWS * 512 * 4);
constexpr size_t WS_YG = al256(WS_ML + (size_t)2 * ROWS * 8 * 4);
constexpr size_t WS_MIX = al256(WS_YG + (size_t)ROWS * 512 * 2);
constexpr size_t WS_XA = al256(WS_MIX + (size_t)ROWS * D * 2);
constexpr size_t WS_XB = al256(WS_XA + (size_t)ROWS * D * 4);
constexpr size_t WS_F = al256(WS_XB + (size_t)ROWS * D * 4);
constexpr size_t WS_LIST = al256(WS_F + (size_t)ROWS * D * 2);
constexpr size_t WS_TOKI = al256(WS_LIST + (size_t)NE * ROWS * 4);
constexpr size_t WS_GATE = al256(WS_TOKI + (size_t)ROWS * 4 * 4);
constexpr size_t WS_H = al256(WS_GATE + (size_t)ROWS * 4 * 4);
constexpr size_t WS_Y = al256(WS_H + (size_t)HROWS * DE * 2);
constexpr size_t WS_END = al256(WS_Y + (size_t)HROWS * D * 2);

constexpr int RING_BYTES = 131072, LDSCTL_OFF = 155648, LDS_BYTES = 159744;
constexpr int LC_BAR = 0, LC_TB = 64, LC_CNT = 256, LC_RM = 2048;

constexpr int PGA_IPB = 320, PGA_J0 = 64, PGA_NI = 40;
constexpr int PGA_LAND = 69632, PGA_TILE = 135168;
__device__ __forceinline__ unsigned f2bf(float f) { unsigned u = __builtin_bit_cast(unsigned, f); return (u + 0x7fffu + ((u >> 16) & 1u)) >> 16; }
__device__ __forceinline__ float bf2f(unsigned h) { return __builtin_bit_cast(float, (h & 0xffffu) << 16); }
__device__ __forceinline__ float bfs2f(short h) { return __builtin_bit_cast(float, ((unsigned)(unsigned short)h) << 16); }
__device__ __forceinline__ unsigned cvt_pk_bf16(float lo, float hi) { unsigned r; asm volatile("v_cvt_pk_bf16_f32 %0, %1, %2" : "=v"(r) : "v"(lo), "v"(hi)); return r; }
__device__ __forceinline__ float wave_sum(float v) {
#pragma unroll
    for (int o = 1; o < 64; o <<= 1) v += __shfl_xor(v, o);
    return v;
}
__device__ __forceinline__ float sigmoid_(float x) { return __builtin_amdgcn_rcpf(1.f + __builtin_amdgcn_exp2f(-1.4426950408889634f * x)); }
__device__ __forceinline__ float silu_(float x) { return x * sigmoid_(x); }
__device__ __forceinline__ float gelu_tanh_(float x) { const float u = 0.7978845608028654f * (x + 0.044715f * x * x * x); return x * __builtin_amdgcn_rcpf(1.f + __builtin_amdgcn_exp2f(-2.8853900817779268f * u)); }
__device__ __forceinline__ void sincos_ang(float ang, float& s, float& c) { float t = ang * 0.15915494309189535f; t = t - floorf(t); s = __builtin_amdgcn_sinf(t); c = __builtin_amdgcn_cosf(t); }
__device__ __forceinline__ int opaque_tid() { int t = threadIdx.x; asm volatile("" : "+v"(t)); return t; }
__device__ __forceinline__ unsigned pk4_fp8(float a, float b, float c, float d) { int r = __builtin_amdgcn_cvt_pk_fp8_f32(a, b, 0, false); r = __builtin_amdgcn_cvt_pk_fp8_f32(c, d, r, true); return (unsigned)r; }
constexpr float W8_SCALE = 64.f, W8_INV = 1.f / 64.f;
__device__ __forceinline__ int lane_now() { int l; asm volatile("v_mbcnt_lo_u32_b32 %0, -1, 0\n\tv_mbcnt_hi_u32_b32 %0, -1, %0" : "=v"(l)); return l; }
struct PgA { const float* wgu; const float* wdn; unsigned char* WGU8; unsigned char* WDN8; int it0; int c0; };
__device__ __forceinline__ void pga_decode(const PgA& P, int j, const float*& src, unsigned char*& dst, int& ldk) {
    const int idx = (j + PGA_J0) * 256 + P.it0;
    if (idx < 32768 || (idx >= 49152 && idx < 81920)) { const int gi = idx < 32768 ? idx : idx - 16384, e = gi >> 10, q = gi & 1023, kt = q >> 5, nt = q & 31; ldk = 2048;
        src = P.wgu + (size_t)e * 2048 * 2048 + (size_t)kt * 64 * 2048 + nt * 64; dst = P.WGU8 + (size_t)e * 2048 * 2048 + (size_t)nt * 64 * 2048 + kt * 64; }
    else { const int di = idx < 49152 ? idx - 32768 : idx - 81920 + 16384, e = di >> 9, q = di & 511, kt = q >> 5, nt = q & 31; ldk = 1024;
        src = P.wdn + (size_t)e * 1024 * 2048 + (size_t)kt * 64 * 2048 + nt * 64; dst = P.WDN8 + (size_t)e * 2048 * 1024 + (size_t)nt * 64 * 1024 + kt * 64; }
}
__device__ __forceinline__ void pga_rb(const PgA& P, LAS unsigned char* lds, int s, int nissue, int wid) {
    const int hf = wid >> 2, u = (wid & 3) * 64 + lane_now(), n = u >> 2, c = u & 3;
#pragma unroll
    for (int t = 0; t < 2; ++t) { const int ia = P.c0 + 4 * (s - 2) + 2 * hf + t;
      if (s >= 2 && s - 2 < nissue && ia < PGA_IPB) { const float* src; unsigned char* dst; int ldk; pga_decode(P, ia, src, dst, ldk); (void)src;
        LAS unsigned char* T = lds + PGA_TILE + (hf * 2 + t) * 4096; u32x4 w;
        w.x = *(const LAS unsigned*)(T + (n * 16 + ((4 * c + 0 + (n >> 2)) & 15)) * 4); w.y = *(const LAS unsigned*)(T + (n * 16 + ((4 * c + 1 + (n >> 2)) & 15)) * 4);
        w.z = *(const LAS unsigned*)(T + (n * 16 + ((4 * c + 2 + (n >> 2)) & 15)) * 4); w.w = *(const LAS unsigned*)(T + (n * 16 + ((4 * c + 3 + (n >> 2)) & 15)) * 4);
        *(u32x4*)(dst + (size_t)n * ldk + c * 16) = w; } }
}
__device__ __forceinline__ void pga_ci(const PgA& P, LAS unsigned char* lds, int s, int nissue, int wid) {
    const int hf = wid >> 2, ln = lane_now(), u = (wid & 3) * 64 + ln, kq = u >> 4, n4 = u & 15;
#pragma unroll
    for (int t = 0; t < 2; ++t) { const int ib = P.c0 + 4 * (s - 1) + 2 * hf + t;
      if (s >= 1 && s - 1 < nissue && ib < PGA_IPB) { LAS unsigned char* T = lds + PGA_TILE + (hf * 2 + t) * 4096; const LAS unsigned char* L = lds + PGA_LAND + t * 32768 + wid * 1024 + ln * 16;
#pragma unroll
        for (int e = 0; e < 4; ++e) { const float v0 = *(const LAS float*)(L + e * 4), v1 = *(const LAS float*)(L + 8192 + e * 4), v2 = *(const LAS float*)(L + 16384 + e * 4), v3 = *(const LAS float*)(L + 24576 + e * 4);
            *(LAS unsigned*)(T + ((4 * n4 + e) * 16 + ((kq + n4) & 15)) * 4) = pk4_fp8(v0 * W8_SCALE, v1 * W8_SCALE, v2 * W8_SCALE, v3 * W8_SCALE); } } }
    asm volatile("s_waitcnt lgkmcnt(0)" ::: "memory");
#pragma unroll
    for (int t = 0; t < 2; ++t) { const int ic = P.c0 + 4 * s + 2 * hf + t;
      if (s < nissue && ic < PGA_IPB) { const float* src; unsigned char* dst; int ldk; pga_decode(P, ic, src, dst, ldk); (void)dst; (void)ldk;
        const float* p = src + (size_t)(4 * kq) * 2048 + n4 * 4;
#pragma unroll
        for (int r = 0; r < 4; ++r) __builtin_amdgcn_global_load_lds((const unsigned*)(p + (size_t)r * 2048), (LAS unsigned*)(lds + PGA_LAND + t * 32768 + r * 8192 + wid * 1024), 16, 0, 0); } }
}
#define MFMA16(a, b, c) __builtin_amdgcn_mfma_f32_16x16x32_bf16((a), (b), (c), 0, 0, 0)

#define XB_TMO      128
#define XB_XCNT(j)  (256  + 64 * (j))
#define XB_XSUB(j)  (1280 + 64 * (j))
#define XB_XGEN(j)  (2304 + 64 * (j))
#define XB_TOP      3328
#define XB_TOPGEN   3392
#define XCD_BAR_WORDS 3456
#define XB_SPIN_CAP (1u << 18)
__device__ __forceinline__ unsigned xb_ld(unsigned* p)              { return __hip_atomic_load(p, __ATOMIC_RELAXED, __HIP_MEMORY_SCOPE_AGENT); }
__device__ __forceinline__ unsigned xb_add(unsigned* p, unsigned v) { return __hip_atomic_fetch_add(p, v, __ATOMIC_RELAXED, __HIP_MEMORY_SCOPE_AGENT); }
__device__ __forceinline__ unsigned xb_xcc_id() { return (unsigned)__builtin_amdgcn_s_getreg((3 << 11) | 20) & 0xFu; }
#define XB_SPIN(cond, bar) do { unsigned _sp = 0; while (cond) { __builtin_amdgcn_s_sleep(1); \
    if ((++_sp & 255u) == 0u) { if (xb_ld(&(bar)[XB_TMO])) break; if (_sp > XB_SPIN_CAP) { atomicAdd(&(bar)[XB_TMO], 1u); break; } } } } while (0)
struct XcdBarrier { unsigned* bar; unsigned x; volatile LAS unsigned* st; };
__device__ __forceinline__ XcdBarrier xcd_barrier_post(unsigned* bar, volatile LAS unsigned* st) {
    XcdBarrier b; b.bar = bar; b.x = xb_xcc_id(); b.st = st;
    if (threadIdx.x == 0) (void)xb_add(&bar[XB_XCNT(b.x)], 1u);
    return b;
}
__device__ __forceinline__ void xcd_barrier_complete(unsigned* bar, unsigned x, unsigned& nloc, unsigned& nx) {
    const unsigned G = gridDim.x * gridDim.y * gridDim.z;
    unsigned sum, cnt, mine, sp = 0u;
    for (;;) {
        sum = 0u; cnt = 0u; mine = 0u;
#pragma unroll
        for (unsigned j = 0; j < 16; ++j) { const unsigned c = xb_ld(&bar[XB_XCNT(j)]); sum += c; cnt += (c > 0u) ? 1u : 0u; mine = (j == x) ? c : mine; }
        if (sum == G) break;
        __builtin_amdgcn_s_sleep(1);
        if ((++sp & 255u) == 0u) { if (xb_ld(&bar[XB_TMO])) break; if (sp > XB_SPIN_CAP) { atomicAdd(&bar[XB_TMO], 1u); break; } }
    }
    nloc = mine > 0u ? mine : 1u; nx = cnt > 0u ? cnt : 1u;
}
__device__ __forceinline__ void xcd_barrier(const XcdBarrier& b) {
    asm volatile("s_waitcnt vmcnt(0)" ::: "memory");
    __syncthreads();
    if (threadIdx.x == 0) {
        unsigned* bar = b.bar;
        __builtin_amdgcn_s_waitcnt(0);
        unsigned nloc = b.st[0], nx = b.st[1];
        if (nloc == 0u) { xcd_barrier_complete(bar, b.x, nloc, nx); b.st[0] = nloc; b.st[1] = nx; }
        const unsigned old = xb_add(&bar[XB_XSUB(b.x)], 1u);
        const unsigned gen = old / nloc;
        if (old + 1u == (gen + 1u) * nloc) {
            __builtin_amdgcn_fence(__ATOMIC_RELEASE, "agent");
            asm volatile("s_waitcnt vmcnt(0)" ::: "memory");
            const unsigned og = xb_add(&bar[XB_TOP], 1u);
            const unsigned tg = og / nx;
            if (og + 1u == (tg + 1u) * nx) xb_add(&bar[XB_TOPGEN], 1u);
            else XB_SPIN(xb_ld(&bar[XB_TOPGEN]) == tg, bar);
            __builtin_amdgcn_fence(__ATOMIC_ACQUIRE, "agent");
            xb_add(&bar[XB_XGEN(b.x)], 1u);
            asm volatile("s_waitcnt vmcnt(0)" ::: "memory");
        } else {
            XB_SPIN(xb_ld(&bar[XB_XGEN(b.x)]) == gen, bar);
            __builtin_amdgcn_fence(__ATOMIC_ACQUIRE, "agent");
            asm volatile("s_waitcnt vmcnt(0)" ::: "memory");
        }
    }
    __syncthreads();
}

namespace pg8 {
constexpr int BM = 256, BK = 64, HALF = 128, HTB = HALF * BK * 2, STAGE_BYTES = 8 * HTB, NXCD = 8, WGM = 8;
__device__ __forceinline__ int lds_byte(int r, int c) { const int st = (r >> 4) * 2 + (c >> 5), rr = r & 15, cc = c & 31, ob = rr * 64 + cc * 2; return st * 1024 + (ob ^ (((ob >> 9) & 1) << 5)); }
__device__ __forceinline__ void stage_rc(int b, int& R, int& C) { const int st = b / 1024, sb = b % 1024, swz = sb ^ (((sb >> 9) & 1) << 5); R = (st >> 1) * 16 + swz / 64; C = (st & 1) * 32 + (swz % 64) / 2; }
__device__ __forceinline__ int perm32(int rho) { const int n = rho >> 4, i = rho & 15; return 8 * (i >> 2) + 4 * n + (i & 3); }

struct Unit { const char* A; const char* B; const int* rowmap; int nvalid; int pm, pn, aux; };

template <class Epi, class Sched, bool GATHER, bool FP8 = false>
__device__ __forceinline__ void gemm_phase(LAS unsigned char* lds, const int lda, const int ldb, const int K, const Sched& S, const Epi& E) {
    const int tid = opaque_tid(), wid = __builtin_amdgcn_readfirstlane(tid >> 6), lane = tid & 63, wr = wid >> 2, wc = wid & 3, fr = lane & 15, fq = lane >> 4;
    const int nt = K / BK;
    unsigned voffA[2][2], nvoffA[2][2], voffB[2];
#pragma unroll
    for (int i = 0; i < 2; ++i) { int R, C; stage_rc(tid * 16 + i * 8192, R, C); const int Rb = (R & ~31) + perm32(R & 31);
        voffA[0][i] = (unsigned)(R * lda + C) * 2u; voffA[1][i] = voffA[0][i]; nvoffA[0][i] = voffA[0][i]; nvoffA[1][i] = voffA[0][i]; voffB[i] = (unsigned)(Rb * ldb + C) * 2u; }
    const size_t kstep = (size_t)(BK * 2);
    const size_t hstepA = GATHER ? 0 : (size_t)HALF * lda * 2, hstepB = (size_t)HALF * ldb * 2;
    const unsigned ldsw = (unsigned)wid * 1024u;
    const int aoff = lds_byte(wr * 64 + fr, fq * 8), boff = lds_byte(wc * 32 + fr, fq * 8);
#define PG8_SA(b, h) (((b) * 2 + (h)) * HTB)
#define PG8_SB(b, h) ((4 + (b) * 2 + (h)) * HTB)
#define PG8_STAGE_B(bufoff, gbase) do { _Pragma("unroll") for (int _i = 0; _i < 2; ++_i) \
        __builtin_amdgcn_global_load_lds((const unsigned*)((const char*)(gbase) + voffB[_i]), (LAS unsigned*)(lds + (bufoff) + ldsw + _i * 8192), 16, 0, 0); } while (0)
#define PG8_STAGE_A(bufoff, gbase, h, usenext) do { _Pragma("unroll") for (int _i = 0; _i < 2; ++_i) { \
        const unsigned _o = (GATHER && (usenext)) ? nvoffA[h][_i] : voffA[h][_i]; \
        __builtin_amdgcn_global_load_lds((const unsigned*)((const char*)(gbase) + (h) * hstepA + _o), (LAS unsigned*)(lds + (bufoff) + ldsw + _i * 8192), 16, 0, 0); } } while (0)
#define PG8_LDA(dst, b, h) do { _Pragma("unroll") for (int m = 0; m < 4; ++m) _Pragma("unroll") for (int k = 0; k < 2; ++k) dst[m][k] = *(const LAS bf16x8*)(lds + PG8_SA(b, h) + aoff + m * 2048 + k * 1024); } while (0)
#define PG8_LDB(dst, b, h) do { _Pragma("unroll") for (int n = 0; n < 2; ++n) _Pragma("unroll") for (int k = 0; k < 2; ++k) dst[n][k] = *(const LAS bf16x8*)(lds + PG8_SB(b, h) + boff + n * 2048 + k * 1024); } while (0)
#define PG8_MMA(ai, bj, At, Bt) do { __builtin_amdgcn_s_setprio(1); _Pragma("unroll") for (int m = 0; m < 4; ++m) _Pragma("unroll") for (int n = 0; n < 2; ++n) { \
        if constexpr (FP8) { typedef int v8i_t __attribute__((ext_vector_type(8))); typedef int v4i_t __attribute__((ext_vector_type(4))); \
            const v4i_t _b0 = __builtin_bit_cast(v4i_t, Bt[n][0]), _b1 = __builtin_bit_cast(v4i_t, Bt[n][1]), _a0 = __builtin_bit_cast(v4i_t, At[m][0]), _a1 = __builtin_bit_cast(v4i_t, At[m][1]); \
            const v8i_t _b = {_b0[0], _b0[1], _b0[2], _b0[3], _b1[0], _b1[1], _b1[2], _b1[3]}, _a = {_a0[0], _a0[1], _a0[2], _a0[3], _a1[0], _a1[1], _a1[2], _a1[3]}; \
              \
            asm volatile("v_mfma_scale_f32_16x16x128_f8f6f4 %0, %1, %2, %0, %3, %3 op_sel_hi:[0,0,0]" : "+v"(acc[ai][bj][m][n]) : "v"(_b), "v"(_a), "v"(pg8_scale1)); } \
        else { _Pragma("unroll") for (int k = 0; k < 2; ++k) acc[ai][bj][m][n] = __builtin_amdgcn_mfma_f32_16x16x32_bf16(Bt[n][k], At[m][k], acc[ai][bj][m][n], 0, 0, 0); } } __builtin_amdgcn_s_setprio(0); } while (0)
#define PG8_WAIT_V(n) asm volatile("s_waitcnt vmcnt(" #n ")" ::: "memory")
#define PG8_WAIT_L(n) asm volatile("s_waitcnt lgkmcnt(" #n ")" ::: "memory")
#define PG8_WAIT_VP(post) do { if (post) asm volatile("s_waitcnt vmcnt(%0)" :: "n"(8 + Epi::NST) : "memory"); else PG8_WAIT_V(8); } while (0)
#define PG8_BAR __builtin_amdgcn_s_barrier()
#define PG8_SCHED __builtin_amdgcn_sched_barrier(0)
#define PG8_GOFF(dst, u) do { if constexpr (GATHER) { const int _t = opaque_tid(); int _v[2][2]; _Pragma("unroll") for (int _i = 0; _i < 2; ++_i) { int _R, _C; stage_rc(_t * 16 + _i * 8192, _R, _C); \
        _Pragma("unroll") for (int _h = 0; _h < 2; ++_h) { const int _r = _h * HALF + _R; _v[_h][_i] = (u).rowmap[_r < (u).nvalid ? _r : 0]; } } \
        _Pragma("unroll") for (int _i = 0; _i < 2; ++_i) { int _R, _C; stage_rc(_t * 16 + _i * 8192, _R, _C); _Pragma("unroll") for (int _h = 0; _h < 2; ++_h) dst[_h][_i] = (unsigned)(_v[_h][_i] * lda + _C) * 2u; } } } while (0)
#define PG8_RM_ISSUE(u) __builtin_amdgcn_global_load_lds((const unsigned*)((u).rowmap + (opaque_tid() & 255)), (LAS unsigned*)(lds + LDSCTL_OFF + LC_RM + (wid & 3) * 256), 4, 0, 0)
#define PG8_RM_READ(dst, u) do { const int _t = opaque_tid(); _Pragma("unroll") for (int _i = 0; _i < 2; ++_i) { int _R, _C; stage_rc(_t * 16 + _i * 8192, _R, _C); \
        _Pragma("unroll") for (int _h = 0; _h < 2; ++_h) { const int _r = _h * HALF + _R; const int _e = *(const LAS int*)(lds + LDSCTL_OFF + LC_RM + _r * 4); const int _src = (_r < (u).nvalid) ? _e : 0; dst[_h][_i] = (unsigned)(_src * lda + _C) * 2u; } } } while (0)
    Unit cur, nxt; int ui = 0;
    if (!S.next(0, cur)) return;
    f32x4 acc[2][2][4][2];
    const int pg8_scale1 = 0x7f7f7f7f;
#pragma unroll
    for (int a = 0; a < 2; ++a)
#pragma unroll
        for (int b = 0; b < 2; ++b)
#pragma unroll
            for (int m = 0; m < 4; ++m)
#pragma unroll
                for (int n = 0; n < 2; ++n) { acc[a][b][m][n] = (f32x4){0.f, 0.f, 0.f, 0.f}; }
    bf16x8 At[4][2], B0[2][2], B1[2][2];
    const char* cA = cur.A; const char* cB = cur.B;
    PG8_GOFF(voffA, cur);
    PG8_STAGE_B(PG8_SB(0, 0), cB); PG8_STAGE_B(PG8_SB(0, 1), cB + hstepB); PG8_STAGE_A(PG8_SA(0, 0), cA, 0, false); PG8_STAGE_A(PG8_SA(0, 1), cA, 1, false);
    if (wr == 1) PG8_BAR;
    PG8_WAIT_V(2); PG8_BAR;
    PG8_STAGE_B(PG8_SB(1, 0), cB + kstep); PG8_STAGE_A(PG8_SA(1, 0), cA + kstep, 0, false); PG8_STAGE_B(PG8_SB(1, 1), cB + hstepB + kstep);
    PG8_WAIT_V(6); PG8_BAR;
    for (;;) {
        const bool has_next = S.next(ui + 1, nxt);
        const char* nA = has_next ? nxt.A : cA; const char* nB = has_next ? nxt.B : cB;
        if constexpr (GATHER) { if (has_next) { PG8_RM_ISSUE(nxt); } else {
#pragma unroll
            for (int _h = 0; _h < 2; ++_h)
#pragma unroll
                for (int _i = 0; _i < 2; ++_i) nvoffA[_h][_i] = voffA[_h][_i]; } }
#pragma unroll 1
        for (int t = 0; t < nt; t += 2) {
            const bool last = (t == nt - 2), post = (t == 0) && (ui > 0);
            const char* a1 = cA + (size_t)(t + 1) * kstep;
            const char* a2 = last ? nA : cA + (size_t)(t + 2) * kstep; const char* b2 = last ? nB : cB + (size_t)(t + 2) * kstep;
            const char* a3 = a2 + kstep; const char* b3 = b2 + kstep;
            if constexpr (GATHER) { if (last && has_next) PG8_RM_READ(nvoffA, nxt); }
            PG8_LDB(B0, 0, 0); PG8_LDB(B1, 0, 1); PG8_SCHED; PG8_LDA(At, 0, 0); PG8_STAGE_A(PG8_SA(1, 1), a1, 1, false);
            PG8_WAIT_VP(post); PG8_WAIT_L(0); PG8_BAR; PG8_MMA(0, 0, At, B0); PG8_MMA(0, 1, At, B1); PG8_BAR; PG8_SCHED;
            PG8_LDA(At, 0, 1); PG8_STAGE_B(PG8_SB(0, 0), b2); PG8_STAGE_B(PG8_SB(0, 1), b2 + hstepB); PG8_STAGE_A(PG8_SA(0, 0), a2, 0, last);
            PG8_WAIT_VP(post); PG8_WAIT_L(0); PG8_BAR; PG8_MMA(1, 0, At, B0); PG8_MMA(1, 1, At, B1); PG8_BAR; PG8_SCHED;
            PG8_LDB(B0, 1, 0); PG8_LDB(B1, 1, 1); PG8_SCHED; PG8_LDA(At, 1, 0); PG8_STAGE_A(PG8_SA(0, 1), a2, 1, last);
            PG8_WAIT_V(8); PG8_WAIT_L(0); PG8_BAR; PG8_MMA(0, 0, At, B0); PG8_MMA(0, 1, At, B1); PG8_BAR; PG8_SCHED;
            PG8_LDA(At, 1, 1); PG8_STAGE_B(PG8_SB(1, 0), b3); PG8_STAGE_B(PG8_SB(1, 1), b3 + hstepB); PG8_STAGE_A(PG8_SA(1, 0), a3, 0, last);
            PG8_WAIT_V(8); PG8_WAIT_L(0); PG8_BAR; PG8_MMA(1, 0, At, B0); PG8_MMA(1, 1, At, B1); PG8_BAR; PG8_SCHED;
        }
        if (wr == 0) PG8_BAR;
        if constexpr (FP8) asm volatile("s_nop 15\n\ts_nop 15" ::: "memory");
        E(acc, cur, wr, wc, fr, fq);
        if (!has_next) break;
#pragma unroll
        for (int a = 0; a < 2; ++a)
#pragma unroll
            for (int b = 0; b < 2; ++b)
#pragma unroll
                for (int m = 0; m < 4; ++m)
#pragma unroll
                    for (int n = 0; n < 2; ++n) { acc[a][b][m][n] = (f32x4){0.f, 0.f, 0.f, 0.f}; }
        cur = nxt; cA = nA; cB = nB; ++ui;
        if constexpr (GATHER) {
#pragma unroll
            for (int _h = 0; _h < 2; ++_h)
#pragma unroll
                for (int _i = 0; _i < 2; ++_i) voffA[_h][_i] = nvoffA[_h][_i]; }
        if (wr == 1) PG8_BAR;
    }
    PG8_WAIT_V(0);
    PG8_BAR;
#undef PG8_SA
#undef PG8_SB
#undef PG8_STAGE_A
#undef PG8_STAGE_B
#undef PG8_LDA
#undef PG8_LDB
#undef PG8_MMA
#undef PG8_WAIT_V
#undef PG8_WAIT_L
#undef PG8_WAIT_VP
#undef PG8_BAR
#undef PG8_SCHED
#undef PG8_GOFF
#undef PG8_RM_ISSUE
#undef PG8_RM_READ
}

struct DenseSched {
    const char* A; const char* B; int lda, ldb, nM, nN, nwg, G, c;
    __device__ __forceinline__ void init(const void* A_, int lda_, int nM_, const void* B_, int ldb_, int nN_, int G_, int c_) { A = (const char*)A_; B = (const char*)B_; lda = lda_; ldb = ldb_; nM = nM_; nN = nN_; nwg = nM * nN; G = G_; c = c_; }
    __device__ __forceinline__ bool next(int i, Unit& u) const {
        const long L = (long)i * G + c; if (L >= nwg) return false;
        int wgid = (int)L; { const int q = nwg / NXCD, r = nwg % NXCD, xcd = wgid % NXCD, off = wgid / NXCD; wgid = (xcd < r ? xcd * (q + 1) : r * (q + 1) + (xcd - r) * q) + off; }
        const int nig = WGM * nN, gid = wgid / nig, fm = gid * WGM, gsz = (nM - fm) < WGM ? (nM - fm) : WGM;
        u.pm = fm + ((wgid % nig) % gsz); u.pn = (wgid % nig) / gsz; u.aux = 0; u.rowmap = nullptr; u.nvalid = 256;
        u.A = A + (size_t)u.pm * 256 * lda * 2; u.B = B + (size_t)u.pn * 256 * ldb * 2; return true;
    }
};
struct BatchSched {
    const char* A; const char* B; size_t sA, sB; int lda, ldb, nM, nN, nb, G, c;
    __device__ __forceinline__ bool next(int i, Unit& u) const {
        const int L = i * G + c; const int per = nM * nN; if (L >= nb * per) return false;
        const int g = L / per, r = L % per; u.aux = g; u.pm = r / nN; u.pn = r % nN; u.rowmap = nullptr; u.nvalid = 256;
        u.A = A + (size_t)g * sA + (size_t)u.pm * 256 * lda * 2; u.B = B + (size_t)g * sB + (size_t)u.pn * 256 * ldb * 2; return true;
    }
};
struct MoeSched {
    const LAS int* tb; const LAS int* cnt; const char* A; const char* B; size_t sB; const int* list; int lda, ldb, nN, G, c; bool gather;
    __device__ __forceinline__ bool next(int i, Unit& u) const {
        const int L = i * G + c; const int T = tb[NE]; if (L >= T * nN) return false;
        const int tile = L / nN; u.pn = L % nN; int e = 0;
        for (int k = 1; k < NE; ++k) e += (tb[k] <= tile) ? 1 : 0;
        const int mt = tile - tb[e]; u.aux = e; u.pm = tile;
        u.B = B + (size_t)e * sB + (size_t)u.pn * 256 * ldb * 2;
        if (gather) { u.A = A; u.rowmap = list + (size_t)e * ROWS + mt * 256; int nv = cnt[e] - mt * 256; u.nvalid = nv > 256 ? 256 : nv; }
        else { u.A = A + (size_t)tile * 256 * lda * 2; u.rowmap = nullptr; u.nvalid = 256; }
        return true;
    }
};
}

#define EPI_LOOP for (int ai = 0; ai < 2; ++ai) _Pragma("unroll") for (int m = 0; m < 4; ++m) _Pragma("unroll") for (int bj = 0; bj < 2; ++bj)
struct EpiInProj {
    static constexpr int NST = 16;
    bf16_t* Z; bf16_t* UPX;
    __device__ __forceinline__ void operator()(const f32x4 (&acc)[2][2][4][2], const pg8::Unit& u, int wr, int wc, int fr, int fq) const {
        const bool isu = (u.pn == 10 || u.pn == 11);
#pragma unroll
        EPI_LOOP {
            const int r = u.pm * 256 + ai * 128 + wr * 64 + m * 16 + fr, c = u.pn * 256 + bj * 128 + wc * 32 + 8 * fq;
            const f32x4 v0 = acc[ai][bj][m][0], v1 = acc[ai][bj][m][1];
            u32x4 w; w.x = cvt_pk_bf16(v0[0], v0[1]); w.y = cvt_pk_bf16(v0[2], v0[3]); w.z = cvt_pk_bf16(v1[0], v1[1]); w.w = cvt_pk_bf16(v1[2], v1[3]);
            if (isu) { const int cu = c - ZC_U, g = cu >> 4, cc = cu & 15; *(u32x4*)(UPX + ((size_t)(g * 512 + (r >> 5)) * 768 + (r & 31) * 16 + cc)) = w; }
            else *(u32x4*)(Z + (size_t)r * INC + c) = w;
        }
    }
};
__device__ __forceinline__ void ld8_bf16(const bf16_t* p, f32x4& a, f32x4& b) { const bf16x8 v = *(const bf16x8*)p; a = (f32x4){bfs2f(v[0]), bfs2f(v[1]), bfs2f(v[2]), bfs2f(v[3])}; b = (f32x4){bfs2f(v[4]), bfs2f(v[5]), bfs2f(v[6]), bfs2f(v[7])}; }
__device__ __forceinline__ void st8_bf16(bf16_t* p, const f32x4 a, const f32x4 b) { u32x4 w; w.x = cvt_pk_bf16(a[0], a[1]); w.y = cvt_pk_bf16(a[2], a[3]); w.z = cvt_pk_bf16(b[0], b[1]); w.w = cvt_pk_bf16(b[2], b[3]); *(u32x4*)p = w; }
struct EpiOut {
    static constexpr int NST = 16;
    const float* xc; const float* xl; const bf16_t* xb; bf16_t* X1; const float* modl; int row0; int accum;
    __device__ __forceinline__ void operator()(const f32x4 (&acc)[2][2][4][2], const pg8::Unit& u, int wr, int wc, int fr, int fq) const {
        f32x4 gg[2][2];
#pragma unroll
        for (int bj = 0; bj < 2; ++bj) { const float* g1 = modl + ((row0 + u.pm * 256) < CTXL ? 12288 : 0) + 2 * 2048 + u.pn * 256 + bj * 128 + wc * 32 + 8 * fq; gg[bj][0] = *(const f32x4*)g1; gg[bj][1] = *(const f32x4*)(g1 + 4); }
#pragma unroll
        for (int ai = 0; ai < 2; ++ai)
#pragma unroll
        for (int mh = 0; mh < 2; ++mh) {
            u32x4 raw[2][2][2];
            const bool bfm = accum || (xb != nullptr);
#pragma unroll
            for (int ml = 0; ml < 2; ++ml)
#pragma unroll
                for (int bj = 0; bj < 2; ++bj) { const int r = row0 + u.pm * 256 + ai * 128 + wr * 64 + (mh * 2 + ml) * 16 + fr, c = u.pn * 256 + bj * 128 + wc * 32 + 8 * fq;
                    const size_t eo = (size_t)r * D + c; const char* pb_ = accum ? (const char*)(X1 + eo) : (const char*)(xb + eo); const char* pf_ = (const char*)((r < CTXL ? xc : xl) + eo);
                    const char* p0 = bfm ? pb_ : pf_; raw[ml][bj][0] = *(const u32x4*)p0; raw[ml][bj][1] = *(const u32x4*)(p0 + (bfm ? 0 : 16)); }
#pragma unroll
            for (int ml = 0; ml < 2; ++ml)
#pragma unroll
                for (int bj = 0; bj < 2; ++bj) { const int m = mh * 2 + ml; const int r = row0 + u.pm * 256 + ai * 128 + wr * 64 + m * 16 + fr, c = u.pn * 256 + bj * 128 + wc * 32 + 8 * fq;
                    const u32x4 w0 = raw[ml][bj][0], w1 = raw[ml][bj][1]; f32x4 x0, x1;
#pragma unroll
                    for (int q = 0; q < 4; ++q) { const unsigned hw = q < 2 ? (q == 0 ? w0.x : w0.y) : (q == 2 ? w0.z : w0.w);
                        const float b0 = __builtin_bit_cast(float, hw << 16), b1 = __builtin_bit_cast(float, hw & 0xffff0000u);
                        const float f0 = __builtin_bit_cast(float, q < 2 ? (q == 0 ? w0.x : w0.z) : (q == 2 ? w1.x : w1.z)), f1 = __builtin_bit_cast(float, q < 2 ? (q == 0 ? w0.y : w0.w) : (q == 2 ? w1.y : w1.w));
                        const float e0 = bfm ? b0 : f0, e1 = bfm ? b1 : f1;
                        if (q < 2) { x0[2 * q] = e0; x0[2 * q + 1] = e1; } else { x1[2 * q - 4] = e0; x1[2 * q - 3] = e1; } }
                    st8_bf16(X1 + (size_t)r * D + c, x0 + gg[bj][0] * (acc[ai][bj][m][0] * W8_INV), x1 + gg[bj][1] * (acc[ai][bj][m][1] * W8_INV)); }
        }
    }
};
struct EpiGateUp {
    static constexpr int NST = 16;
    unsigned char* H; const float* bgu;
    __device__ __forceinline__ void operator()(const f32x4 (&acc)[2][2][4][2], const pg8::Unit& u, int wr, int wc, int fr, int fq) const {
        f32x4 bb[2][2];
#pragma unroll
        for (int bj = 0; bj < 2; ++bj) { const float* b = bgu + u.aux * 2048 + u.pn * 256 + bj * 128 + wc * 32 + 8 * fq; bb[bj][0] = *(const f32x4*)b; bb[bj][1] = *(const f32x4*)(b + 4); }
#pragma unroll
        EPI_LOOP {
            const int r = u.pm * 256 + ai * 128 + wr * 64 + m * 16 + fr, c = u.pn * 256 + bj * 128 + wc * 32 + 8 * fq;
            const f32x4 v0 = acc[ai][bj][m][0] * W8_INV + bb[bj][0], v1 = acc[ai][bj][m][1] * W8_INV + bb[bj][1];
            float o[4];
#pragma unroll
            for (int q = 0; q < 4; ++q) { const float gt = fminf(q < 2 ? v0[2 * q] : v1[2 * q - 4], 7.f); const float up = fminf(fmaxf(q < 2 ? v0[2 * q + 1] : v1[2 * q - 3], -7.f), 7.f);
                o[q] = (up + 1.f) * gt * sigmoid_(gt * 1.702f); }
            *(unsigned*)(H + (size_t)r * DE + (c >> 1)) = pk4_fp8(o[0], o[1], o[2], o[3]);
        }
    }
};
struct EpiDown {
    static constexpr int NST = 16;
    bf16_t* Y; const float* bd;
    __device__ __forceinline__ void operator()(const f32x4 (&acc)[2][2][4][2], const pg8::Unit& u, int wr, int wc, int fr, int fq) const {
        f32x4 bb[2][2];
#pragma unroll
        for (int bj = 0; bj < 2; ++bj) { const float* b = bd + u.aux * 2048 + u.pn * 256 + bj * 128 + wc * 32 + 8 * fq; bb[bj][0] = *(const f32x4*)b; bb[bj][1] = *(const f32x4*)(b + 4); }
#pragma unroll
        EPI_LOOP {
            const int r = u.pm * 256 + ai * 128 + wr * 64 + m * 16 + fr, c = u.pn * 256 + bj * 128 + wc * 32 + 8 * fq;
            const f32x4 v0 = acc[ai][bj][m][0] * W8_INV + bb[bj][0], v1 = acc[ai][bj][m][1] * W8_INV + bb[bj][1];
            u32x4 w; w.x = cvt_pk_bf16(v0[0], v0[1]); w.y = cvt_pk_bf16(v0[2], v0[3]); w.z = cvt_pk_bf16(v1[0], v1[1]); w.w = cvt_pk_bf16(v1[2], v1[3]);
            *(u32x4*)(Y + (size_t)r * D + c) = w;
        }
    }
};
struct EpiS1 {
    static constexpr int NST = 32;
    float* E;
    __device__ __forceinline__ void operator()(const f32x4 (&acc)[2][2][4][2], const pg8::Unit& u, int wr, int wc, int fr, int fq) const {
#pragma unroll
        EPI_LOOP {
            const int r = u.pm * 256 + ai * 128 + wr * 64 + m * 16 + fr, c = bj * 128 + wc * 32 + 8 * fq;
            float* p = E + ((size_t)u.aux * 512 + r) * 256 + c; *(f32x4*)p = acc[ai][bj][m][0]; *(f32x4*)(p + 4) = acc[ai][bj][m][1];
        }
    }
};
struct EpiS3 {
    static constexpr int NST = 0;
    bf16_t* YG;
    __device__ __forceinline__ void operator()(const f32x4 (&acc)[2][2][4][2], const pg8::Unit& u, int wr, int wc, int fr, int fq) const {
#pragma unroll
        EPI_LOOP {
            const int j = u.pm * 256 + ai * 128 + wr * 64 + m * 16 + fr, n = u.pn * 256 + bj * 128 + wc * 32 + 8 * fq;
            if (j < NCH) { const f32x4 v0 = acc[ai][bj][m][0], v1 = acc[ai][bj][m][1];
                u32x4 w; w.x = cvt_pk_bf16(gelu_tanh_(v0[0]), gelu_tanh_(v0[1])); w.y = cvt_pk_bf16(gelu_tanh_(v0[2]), gelu_tanh_(v0[3]));
                w.z = cvt_pk_bf16(gelu_tanh_(v1[0]), gelu_tanh_(v1[1])); w.w = cvt_pk_bf16(gelu_tanh_(v1[2]), gelu_tanh_(v1[3]));
                *(u32x4*)(YG + (size_t)(32 * j + (n >> 4)) * 512 + 16 * u.aux + (n & 15)) = w; }
        }
    }
};
struct EpiGLU {
    static constexpr int NST = 16;
    const bf16_t* YG; unsigned char* MIX8; const float* bglu;
    __device__ __forceinline__ void operator()(const f32x4 (&acc)[2][2][4][2], const pg8::Unit& u, int wr, int wc, int fr, int fq) const {
        f32x4 bb[2][2];
#pragma unroll
        for (int bj = 0; bj < 2; ++bj) { const float* b = bglu + u.pn * 256 + bj * 128 + wc * 32 + 8 * fq; bb[bj][0] = *(const f32x4*)b; bb[bj][1] = *(const f32x4*)(b + 4); }
#pragma unroll
        for (int ai = 0; ai < 2; ++ai) {
        bf16x8 yy[4][2];
#pragma unroll
        for (int m = 0; m < 4; ++m)
#pragma unroll
            for (int bj = 0; bj < 2; ++bj) yy[m][bj] = *(const bf16x8*)(YG + (size_t)(u.pm * 256 + ai * 128 + wr * 64 + m * 16 + fr) * 512 + u.pn * 256 + bj * 128 + wc * 32 + 8 * fq);
#pragma unroll
        for (int m = 0; m < 4; ++m)
#pragma unroll
        for (int bj = 0; bj < 2; ++bj) {
            const int r = u.pm * 256 + ai * 128 + wr * 64 + m * 16 + fr, c = u.pn * 256 + bj * 128 + wc * 32 + 8 * fq;
            const bf16x8 y = yy[m][bj];
            const f32x4 v0 = acc[ai][bj][m][0] + bb[bj][0], v1 = acc[ai][bj][m][1] + bb[bj][1];
            u32x2 w; w.x = pk4_fp8(bfs2f(y[0]) * sigmoid_(v0[0]), bfs2f(y[1]) * sigmoid_(v0[1]), bfs2f(y[2]) * sigmoid_(v0[2]), bfs2f(y[3]) * sigmoid_(v0[3]));
            w.y = pk4_fp8(bfs2f(y[4]) * sigmoid_(v1[0]), bfs2f(y[5]) * sigmoid_(v1[1]), bfs2f(y[6]) * sigmoid_(v1[2]), bfs2f(y[7]) * sigmoid_(v1[3]));
            *(u32x2*)(MIX8 + (size_t)r * D + 1536 + c) = w;
        }
        }
    }
};

namespace att {
constexpr int DH = 128, NW = 8, QBLK = 32, KVBLK = 64;
constexpr float SCALE = 0.088388347648318440f;
constexpr float THR = 8.f;
constexpr int LDQ = INC, LDK = INC, LDO = 512;
constexpr size_t SHM_V = KVBLK * DH * 2, SHM_K = KVBLK * DH * 2, SHM_ATTN = 2 * SHM_V + 2 * SHM_K + NW * 64 * 4;
#define KSWZ(row, colB) ((row) * 256 + ((colB) ^ (((row) & 7) << 4)))
#define SBAR() __builtin_amdgcn_sched_barrier(0)
__device__ __forceinline__ int crow(int r, int hi) { return (r & 3) + 8 * (r >> 2) + 4 * hi; }
__device__ __forceinline__ unsigned cvtpk(float lo, float hi) { unsigned r; asm volatile("v_cvt_pk_bf16_f32 %0, %1, %2" : "=v"(r) : "v"(lo), "v"(hi)); return r; }
__device__ __forceinline__ void partialSM(f32x16& p0, f32x16& p1, float& m_reg, float& mn, float& alpha) {
  constexpr float C = SCALE * 1.4426950408889634f;
  float pmax = p0[0];
#pragma unroll
  for (int r = 1; r < 16; ++r) pmax = fmaxf(pmax, p0[r]);
#pragma unroll
  for (int r = 0; r < 16; ++r) pmax = fmaxf(pmax, p1[r]);
  { auto rr = __builtin_amdgcn_permlane32_swap(__float_as_uint(pmax), __float_as_uint(pmax), false, false);
    pmax = fmaxf(__uint_as_float(rr[0]), __uint_as_float(rr[1])); }
  if (__builtin_expect(__all(pmax - m_reg <= THR / SCALE), 1)) { mn = m_reg; alpha = 1.f; }
  else { mn = fmaxf(m_reg, pmax); alpha = __builtin_amdgcn_exp2f((m_reg - mn) * C); m_reg = mn; }
  float mnC = -mn * C;
#pragma unroll
  for (int r = 0; r < 16; ++r) p0[r] = fmaf(p0[r], C, mnC);
#pragma unroll
  for (int r = 0; r < 16; ++r) p1[r] = fmaf(p1[r], C, mnC);
#pragma unroll
  for (int r = 0; r < 16; ++r) p0[r] = __builtin_amdgcn_exp2f(p0[r]);
}
__device__ __forceinline__ void finishSM(f32x16& p0, f32x16& p1, float alpha, float& l_reg, bf16x8& pa0, bf16x8& pa1, bf16x8& pa2, bf16x8& pa3) {
#pragma unroll
  for (int r = 0; r < 16; ++r) p1[r] = __builtin_amdgcn_exp2f(p1[r]);
  float ps = 0;
#pragma unroll
  for (int r = 0; r < 16; ++r) ps += p0[r];
#pragma unroll
  for (int r = 0; r < 16; ++r) ps += p1[r];
  { auto rr = __builtin_amdgcn_permlane32_swap(__float_as_uint(ps), __float_as_uint(ps), false, false);
    ps = __uint_as_float(rr[0]) + __uint_as_float(rr[1]); }
  l_reg = l_reg * alpha + ps;
#define PK4(P, BASE, OUT) do { unsigned a0 = cvtpk(P[BASE + 0], P[BASE + 1]), a1 = cvtpk(P[BASE + 2], P[BASE + 3]);   \
    unsigned b0 = cvtpk(P[BASE + 4], P[BASE + 5]), b1 = cvtpk(P[BASE + 6], P[BASE + 7]);                              \
    auto r0 = __builtin_amdgcn_permlane32_swap(a0, b0, false, false); auto r1 = __builtin_amdgcn_permlane32_swap(a1, b1, false, false); \
    u32x4 w = {r0[0], r1[0], r0[1], r1[1]}; OUT = __builtin_bit_cast(bf16x8, w); } while (0)
  PK4(p0, 0, pa0); PK4(p0, 8, pa1); PK4(p1, 0, pa2); PK4(p1, 8, pa3);
#undef PK4
}
__device__ __forceinline__ void qkt(f32x16& p0, f32x16& p1, const bf16_t* Ks, const bf16x8* qr, int r32, int hi) {
  p0 = f32x16{}; p1 = f32x16{};
#pragma unroll
  for (int d0 = 0; d0 < 8; ++d0) { int cb = (d0 * 16 + hi * 8) * 2;
    bf16x8 b0 = *reinterpret_cast<const bf16x8*>((const char*)Ks + KSWZ(r32, cb));
    bf16x8 b1 = *reinterpret_cast<const bf16x8*>((const char*)Ks + KSWZ(32 + r32, cb));
    p0 = __builtin_amdgcn_mfma_f32_32x32x16_bf16(b0, qr[d0], p0, 0, 0, 0);
    p1 = __builtin_amdgcn_mfma_f32_32x32x16_bf16(b1, qr[d0], p1, 0, 0, 0); }
}
__device__ __forceinline__ int v_st(int k, int c) { const int kk = (k & ~0xC) | ((k & 4) << 1) | ((k & 8) >> 1); return ((kk >> 3) * 4 + (c >> 5)) * 512 + ((kk & 7) * 32 + (c & 31)) * 2; }
__device__ __forceinline__ int v_rd_base(int lane) { return ((lane & 3) << 3) | (((lane >> 2) & 3) << 6) | (((lane >> 4) & 1) << 5) | (((lane >> 5) & 1) << 8); }
constexpr int v_rd_off(int d0, int ks, int half) { return d0 * 512 + ks * 4096 + half * 2048; }
template <int OFF> __device__ __forceinline__ s16x4 tr_read(int vb) {
  s16x4 r; asm volatile("ds_read_b64_tr_b16 %0, %1 offset:%2" : "=&v"(r) : "v"(vb), "i"(OFF) : "memory"); return r;
}
template <int D0> __device__ __forceinline__ void pv_one(f32x16& od, int vb, bf16x8 pa0, bf16x8 pa1, bf16x8 pa2, bf16x8 pa3) {
  const s16x4 l0 = tr_read<v_rd_off(D0, 0, 0)>(vb), h0 = tr_read<v_rd_off(D0, 0, 1)>(vb), l1 = tr_read<v_rd_off(D0, 1, 0)>(vb), h1 = tr_read<v_rd_off(D0, 1, 1)>(vb);
  const s16x4 l2 = tr_read<v_rd_off(D0, 2, 0)>(vb), h2 = tr_read<v_rd_off(D0, 2, 1)>(vb), l3 = tr_read<v_rd_off(D0, 3, 0)>(vb), h3 = tr_read<v_rd_off(D0, 3, 1)>(vb);
  asm volatile("s_waitcnt lgkmcnt(0)" ::: "memory"); SBAR();
#define PK(L, H) (bf16x8){L[0], L[1], L[2], L[3], H[0], H[1], H[2], H[3]}
  od = __builtin_amdgcn_mfma_f32_32x32x16_bf16(pa0, PK(l0, h0), od, 0, 0, 0);
  od = __builtin_amdgcn_mfma_f32_32x32x16_bf16(pa1, PK(l1, h1), od, 0, 0, 0);
  od = __builtin_amdgcn_mfma_f32_32x32x16_bf16(pa2, PK(l2, h2), od, 0, 0, 0);
  od = __builtin_amdgcn_mfma_f32_32x32x16_bf16(pa3, PK(l3, h3), od, 0, 0, 0);
#undef PK
}
__device__ __forceinline__ void pv_d0(f32x16* o, int vb, bf16x8 pa0, bf16x8 pa1, bf16x8 pa2, bf16x8 pa3) {
  pv_one<0>(o[0], vb, pa0, pa1, pa2, pa3); pv_one<1>(o[1], vb, pa0, pa1, pa2, pa3); pv_one<2>(o[2], vb, pa0, pa1, pa2, pa3); pv_one<3>(o[3], vb, pa0, pa1, pa2, pa3);
}
template <bool PIGGY>
__device__ __forceinline__ void attn_dense_body(const bf16_t* __restrict__ Qb, const bf16_t* __restrict__ Kh, const bf16_t* __restrict__ Vh,
                                                float* __restrict__ Ob, float* __restrict__ MLb, int seq, char* lds, const PgA PG = PgA{}) {
  const int tid = opaque_tid(), wid = tid >> 6, lane = tid & 63, r32 = lane & 31, hi = lane >> 5;
  const int wid_u = __builtin_amdgcn_readfirstlane(wid); LAS char* lds_las = (LAS char*)lds; (void)wid_u; (void)lds_las;
  bf16_t* V_lds = (bf16_t*)lds; bf16_t* K_lds = (bf16_t*)(lds + 2 * SHM_V);
  float* ws = (float*)(lds + 2 * SHM_V + 2 * SHM_K) + wid * 64; float* li_l = ws; float* al_l = ws + 32;
  float m_reg = -1e30f, l_reg = 0; f32x16 o[4] = {}; bf16x8 qr[8];
  const bf16_t* Qw = Qb + (long)(wid * QBLK + r32) * LDQ + hi * 8;
#pragma unroll
  for (int d0 = 0; d0 < 8; ++d0) qr[d0] = *reinterpret_cast<const bf16x8*>(Qw + d0 * 16);
  const int sr = tid >> 4, sc = (tid & 15) * 8, vst0 = v_st(sr, sc), vst1 = v_st(32 + sr, sc);
  const int vb0 = (int)(uintptr_t)V_lds + v_rd_base(lane);
  bf16x8 s0_vs0, s0_vs1, s0_ks0, s0_ks1, s1_vs0, s1_vs1, s1_ks0, s1_ks1;
#define SLOAD0(k0) do { s0_vs0 = *(const bf16x8*)(&Vh[(long)((k0) + sr) * LDK + sc]); s0_vs1 = *(const bf16x8*)(&Vh[(long)((k0) + 32 + sr) * LDK + sc]); \
    s0_ks0 = *(const bf16x8*)(&Kh[(long)((k0) + sr) * LDK + sc]); s0_ks1 = *(const bf16x8*)(&Kh[(long)((k0) + 32 + sr) * LDK + sc]); } while (0)
#define SLOAD1(k0) do { s1_vs0 = *(const bf16x8*)(&Vh[(long)((k0) + sr) * LDK + sc]); s1_vs1 = *(const bf16x8*)(&Vh[(long)((k0) + 32 + sr) * LDK + sc]); \
    s1_ks0 = *(const bf16x8*)(&Kh[(long)((k0) + sr) * LDK + sc]); s1_ks1 = *(const bf16x8*)(&Kh[(long)((k0) + 32 + sr) * LDK + sc]); } while (0)
#define SWRITE0(b) do { *(bf16x8*)((char*)V_lds + (b) * SHM_V + vst0) = s0_vs0; *(bf16x8*)((char*)V_lds + (b) * SHM_V + vst1) = s0_vs1; int kc = sc * 2; \
    *(bf16x8*)((char*)K_lds + (b) * SHM_K + KSWZ(sr, kc)) = s0_ks0; *(bf16x8*)((char*)K_lds + (b) * SHM_K + KSWZ(32 + sr, kc)) = s0_ks1; } while (0)
#define SWRITE1(b) do { *(bf16x8*)((char*)V_lds + (b) * SHM_V + vst0) = s1_vs0; *(bf16x8*)((char*)V_lds + (b) * SHM_V + vst1) = s1_vs1; int kc = sc * 2; \
    *(bf16x8*)((char*)K_lds + (b) * SHM_K + KSWZ(sr, kc)) = s1_ks0; *(bf16x8*)((char*)K_lds + (b) * SHM_K + KSWZ(32 + sr, kc)) = s1_ks1; } while (0)
#define SWAIT() asm volatile("s_waitcnt vmcnt(4)" ::: "memory")
#define RESC(a) do { if (__any((a) < 1.f)) { if (hi == 0) al_l[r32] = (a); asm volatile("s_waitcnt lgkmcnt(0)" ::: "memory"); \
    _Pragma("unroll") for (int d = 0; d < 4; ++d) _Pragma("unroll") for (int r = 0; r < 16; ++r) o[d][r] *= al_l[crow(r, hi)]; } } while (0)
  f32x16 pA0, pA1, pB0, pB1; float mnA, mnB, alA, alB; bf16x8 pa0, pa1, pa2, pa3; const int NT = seq / KVBLK;
  SLOAD0(0); asm volatile("s_waitcnt vmcnt(0)" ::: "memory"); SWRITE0(0); __syncthreads();
  qkt(pA0, pA1, K_lds, qr, r32, hi); partialSM(pA0, pA1, m_reg, mnA, alA);
  SLOAD1(KVBLK); if (2 < NT) SLOAD0(2 * KVBLK);
#define PGA_P1(sidx) do { if constexpr (PIGGY) pga_rb(PG, (LAS unsigned char*)(LAS char*)lds_las, (sidx), PGA_NI, wid_u); } while (0)
#define PGA_P2(sidx) do { if constexpr (PIGGY) pga_ci(PG, (LAS unsigned char*)(LAS char*)lds_las, (sidx), PGA_NI, wid_u); } while (0)
  SWAIT(); SWRITE1(1); __syncthreads();
  for (int j = 1; j + 1 < NT; j += 2) {
    PGA_P2(j - 1);
    SBAR(); qkt(pB0, pB1, (bf16_t*)((char*)K_lds + SHM_K), qr, r32, hi);
    finishSM(pA0, pA1, alA, l_reg, pa0, pa1, pa2, pa3); SBAR();
    SLOAD1((j + 2) * KVBLK); SBAR();
    pv_d0(o, vb0, pa0, pa1, pa2, pa3); partialSM(pB0, pB1, m_reg, mnB, alB);
    __syncthreads(); SWAIT(); SWRITE0(0); PGA_P1(j);
    RESC(alB); __syncthreads();
    PGA_P2(j);
    SBAR(); qkt(pA0, pA1, K_lds, qr, r32, hi);
    finishSM(pB0, pB1, alB, l_reg, pa0, pa1, pa2, pa3); SBAR();
    if (j + 3 < NT) SLOAD0((j + 3) * KVBLK); SBAR();
    pv_d0(o, vb0 + (int)SHM_V, pa0, pa1, pa2, pa3); partialSM(pA0, pA1, m_reg, mnA, alA);
    __syncthreads(); SWAIT(); SWRITE1(1); if constexpr (PIGGY) { if (j + 3 >= NT) asm volatile("s_waitcnt vmcnt(0)" ::: "memory"); } PGA_P1(j + 1);
    RESC(alA); __syncthreads();
  }
  SBAR(); qkt(pB0, pB1, (bf16_t*)((char*)K_lds + SHM_K), qr, r32, hi);
  finishSM(pA0, pA1, alA, l_reg, pa0, pa1, pa2, pa3); SBAR();
  pv_d0(o, vb0, pa0, pa1, pa2, pa3); partialSM(pB0, pB1, m_reg, mnB, alB);
  __syncthreads(); RESC(alB);
  finishSM(pB0, pB1, alB, l_reg, pa0, pa1, pa2, pa3); SBAR();
  pv_d0(o, vb0 + (int)SHM_V, pa0, pa1, pa2, pa3);
  if (hi == 0) { li_l[r32] = l_reg; MLb[(wid * QBLK + r32) * 8 + 0] = m_reg; MLb[(wid * QBLK + r32) * 8 + 1] = l_reg; }
  asm volatile("s_waitcnt lgkmcnt(0)" ::: "memory");
  float rli[16];
#pragma unroll
  for (int r = 0; r < 16; ++r) rli[r] = __builtin_amdgcn_rcpf(li_l[crow(r, hi)]);
  float* Ow = Ob + (long)(wid * QBLK) * LDO;
#pragma unroll
  for (int r = 0; r < 16; ++r) { int orow = crow(r, hi);
#pragma unroll
    for (int d0 = 0; d0 < 4; ++d0) Ow[(long)orow * LDO + d0 * 32 + r32] = o[d0][r] * rli[r]; }
  if constexpr (PIGGY) {
    asm volatile("s_waitcnt vmcnt(0)" ::: "memory"); __syncthreads(); PGA_P2(NT - 2); asm volatile("s_waitcnt lgkmcnt(0)" ::: "memory"); __syncthreads(); PGA_P1(NT - 1);
  }
#undef PGA_P1
#undef PGA_P2
  __syncthreads();
#undef SLOAD0
#undef SLOAD1
#undef SWRITE0
#undef SWRITE1
#undef SWAIT
#undef RESC
}
}

__device__ __forceinline__ void ret_out_unit(LAS unsigned char* lds, unsigned char* ws, const int b, const int h) {
#define Z ((bf16_t*)(ws + WS_Z))
#define SPREV ((bf16_t*)(ws + WS_SPREV))
#define MIX ((bf16_t*)(ws + WS_MIX))
                const int tid = opaque_tid(), lane = tid & 63, wave = __builtin_amdgcn_readfirstlane(tid >> 6), fr = lane & 15, fq = lane >> 4;
                LAS unsigned char* Qs = lds; LAS unsigned char* Ks = lds + 34816; LAS unsigned char* VT = lds + 69632;
                const float l2gf = log2f(1.f - __builtin_amdgcn_exp2f(-5.f - (float)h)), l2gb = log2f(1.f - __builtin_amdgcn_exp2f(-5.f - (float)(3 - h)));
                {
                    const int j = tid >> 2, sub = tid & 3, row = b * 128 + j; const bf16_t* zr = Z + (size_t)row * INC;
                    const bool lat = row >= CTXL; const float tpos = (float)(row - CTXL);
#pragma unroll
                    for (int h8 = 0; h8 < 2; ++h8) { const int dk0 = 16 * sub + 8 * h8;
                        const bf16x8 q1 = *(const bf16x8*)(zr + ZC_RQ + h * 128 + dk0), q2 = *(const bf16x8*)(zr + ZC_RQ + h * 128 + 64 + dk0);
                        const bf16x8 k1 = *(const bf16x8*)(zr + ZC_RK + h * 128 + dk0), k2 = *(const bf16x8*)(zr + ZC_RK + h * 128 + 64 + dk0);
                        float qa[8], qb_[8], ka[8], kb_[8];
#pragma unroll
                        for (int e = 0; e < 8; ++e) { const int dk = dk0 + e; float a1 = bfs2f(q1[e]), a2 = bfs2f(q2[e]), b1 = bfs2f(k1[e]), b2 = bfs2f(k2[e]);
                            if (lat) { const float freq = __builtin_amdgcn_exp2f(-(float)dk * (LOG2_1E4 / 64.f)); float sn, cs; sincos_ang(tpos * freq, sn, cs);
                                const float t1 = a1 * cs - a2 * sn, t2 = a1 * sn + a2 * cs, t3 = b1 * cs - b2 * sn, t4 = b1 * sn + b2 * cs; a1 = t1; a2 = t2; b1 = t3; b2 = t4; }
                            qa[e] = a1; qb_[e] = a2; ka[e] = b1 * 0.08838834764831845f; kb_[e] = b2 * 0.08838834764831845f; }
                        u32x4 w;
                        w.x = cvt_pk_bf16(qa[0], qa[1]); w.y = cvt_pk_bf16(qa[2], qa[3]); w.z = cvt_pk_bf16(qa[4], qa[5]); w.w = cvt_pk_bf16(qa[6], qa[7]); *(LAS u32x4*)(Qs + j * 272 + dk0 * 2) = w;
                        w.x = cvt_pk_bf16(qb_[0], qb_[1]); w.y = cvt_pk_bf16(qb_[2], qb_[3]); w.z = cvt_pk_bf16(qb_[4], qb_[5]); w.w = cvt_pk_bf16(qb_[6], qb_[7]); *(LAS u32x4*)(Qs + j * 272 + (dk0 + 64) * 2) = w;
                        w.x = cvt_pk_bf16(ka[0], ka[1]); w.y = cvt_pk_bf16(ka[2], ka[3]); w.z = cvt_pk_bf16(ka[4], ka[5]); w.w = cvt_pk_bf16(ka[6], ka[7]); *(LAS u32x4*)(Ks + j * 272 + dk0 * 2) = w;
                        w.x = cvt_pk_bf16(kb_[0], kb_[1]); w.y = cvt_pk_bf16(kb_[2], kb_[3]); w.z = cvt_pk_bf16(kb_[4], kb_[5]); w.w = cvt_pk_bf16(kb_[6], kb_[7]); *(LAS u32x4*)(Ks + j * 272 + (dk0 + 64) * 2) = w; }
#pragma unroll
                    for (int q = 0; q < 4; ++q) { const bf16x8 v = *(const bf16x8*)(zr + ZC_RV + h * 128 + 32 * sub + 8 * q);
#pragma unroll
                        for (int e = 0; e < 8; ++e) *(LAS bf16_t*)(VT + (32 * sub + 8 * q + e) * 272 + j * 2) = (bf16_t)v[e]; }
                }
                __syncthreads();
                f32x4 Sx[8], QF[8], QB[8];
#pragma unroll
                for (int n = 0; n < 8; ++n) { Sx[n] = (f32x4){0.f, 0.f, 0.f, 0.f}; QF[n] = (f32x4){0.f, 0.f, 0.f, 0.f}; QB[n] = (f32x4){0.f, 0.f, 0.f, 0.f}; }
                const bf16_t* SPf = SPREV + ((size_t)(b * 4 + h) * 2) * 16384; const bf16_t* SPb = SPf + 16384;
#pragma unroll 2
                for (int k0 = 0; k0 < 128; k0 += 32) { const bf16x8 av = *(const LAS bf16x8*)(Qs + (16 * wave + fr) * 272 + (k0 + fq * 8) * 2);
#pragma unroll
                    for (int n = 0; n < 8; ++n) { const bf16x8 bk = *(const LAS bf16x8*)(Ks + (16 * n + fr) * 272 + (k0 + fq * 8) * 2);
                        const bf16x8 bf_ = *(const bf16x8*)(SPf + (16 * n + fr) * 128 + k0 + fq * 8), bb_ = *(const bf16x8*)(SPb + (16 * n + fr) * 128 + k0 + fq * 8);
                        Sx[n] = MFMA16(bk, av, Sx[n]); QF[n] = MFMA16(bf_, av, QF[n]); QB[n] = MFMA16(bb_, av, QB[n]); } }
                __syncthreads();
                const int ii = 16 * wave + fr;
#pragma unroll
                for (int n = 0; n < 8; ++n) { float pf[4], pbv[4];
#pragma unroll
                    for (int q = 0; q < 4; ++q) { const int jj = 16 * n + 4 * fq + q; const float df = (float)(ii - jj);
                        pf[q] = (ii >= jj) ? Sx[n][q] * __builtin_amdgcn_exp2f(l2gf * df) : 0.f; pbv[q] = (jj >= ii) ? Sx[n][q] * __builtin_amdgcn_exp2f(-l2gb * df) : 0.f; }
                    u32x2 w; w.x = cvt_pk_bf16(pf[0], pf[1]); w.y = cvt_pk_bf16(pf[2], pf[3]); *(LAS u32x2*)(Qs + ii * 272 + (16 * n + 4 * fq) * 2) = w;
                    w.x = cvt_pk_bf16(pbv[0], pbv[1]); w.y = cvt_pk_bf16(pbv[2], pbv[3]); *(LAS u32x2*)(Ks + ii * 272 + (16 * n + 4 * fq) * 2) = w; }
                __syncthreads();
                const float xif = __builtin_amdgcn_exp2f(l2gf * (float)(ii + 1)), xib = __builtin_amdgcn_exp2f(l2gb * (float)(128 - ii));
#pragma unroll
                for (int n = 0; n < 8; ++n) { QF[n] = QF[n] * xif; QB[n] = QB[n] * xib; }
#define YF QF
#define YBk QB
                const int row = b * 128 + ii; const bf16_t* zr = Z + (size_t)row * INC;
                s16x4 gfv[8], gbv[8];
#pragma unroll
                for (int n = 0; n < 8; ++n) { const int dv = 16 * n + 4 * fq; gfv[n] = *(const s16x4*)(zr + ZC_GF + h * 128 + dv); gbv[n] = *(const s16x4*)(zr + ZC_GB + h * 128 + dv); }
#pragma unroll
                for (int k0 = 0; k0 < 128; k0 += 32) { const bf16x8 a_f = *(const LAS bf16x8*)(Qs + (16 * wave + fr) * 272 + (k0 + fq * 8) * 2), a_b = *(const LAS bf16x8*)(Ks + (16 * wave + fr) * 272 + (k0 + fq * 8) * 2);
#pragma unroll
                    for (int n = 0; n < 8; ++n) { const bf16x8 bv = *(const LAS bf16x8*)(VT + (16 * n + fr) * 272 + (k0 + fq * 8) * 2); YF[n] = MFMA16(bv, a_f, YF[n]); YBk[n] = MFMA16(bv, a_b, YBk[n]); } }
                float sf = 0.f, sb = 0.f;
#pragma unroll
                for (int n = 0; n < 8; ++n) { sf += (YF[n][0] + YF[n][1]) + (YF[n][2] + YF[n][3]); sb += (YBk[n][0] + YBk[n][1]) + (YBk[n][2] + YBk[n][3]); }
                sf += __shfl_xor(sf, 16); sf += __shfl_xor(sf, 32); sb += __shfl_xor(sb, 16); sb += __shfl_xor(sb, 32);
                const float mf = sf * (1.f / 128.f), mb = sb * (1.f / 128.f); float vf = 0.f, vb = 0.f;
#pragma unroll
                for (int n = 0; n < 8; ++n) { YF[n] = YF[n] - mf; YBk[n] = YBk[n] - mb; vf += (YF[n][0] * YF[n][0] + YF[n][1] * YF[n][1]) + (YF[n][2] * YF[n][2] + YF[n][3] * YF[n][3]);
                    vb += (YBk[n][0] * YBk[n][0] + YBk[n][1] * YBk[n][1]) + (YBk[n][2] * YBk[n][2] + YBk[n][3] * YBk[n][3]); }
                vf += __shfl_xor(vf, 16); vf += __shfl_xor(vf, 32); vb += __shfl_xor(vb, 16); vb += __shfl_xor(vb, 32);
                const float rf = __builtin_amdgcn_rsqf(vf * (1.f / 128.f) + EPS), rb = __builtin_amdgcn_rsqf(vb * (1.f / 128.f) + EPS);
#pragma unroll
                for (int n = 0; n < 8; ++n) { const int dv = 16 * n + 4 * fq; float o[4];
#pragma unroll
                    for (int q = 0; q < 4; ++q) o[q] = silu_(bfs2f(gfv[n][q])) * YF[n][q] * rf + silu_(bfs2f(gbv[n][q])) * YBk[n][q] * rb;
                    *(unsigned*)((unsigned char*)MIX + (size_t)row * D + h * 128 + dv) = pk4_fp8(o[0], o[1], o[2], o[3]); }
                __syncthreads();
#undef YF
#undef YBk
#undef Z
#undef SPREV
#undef MIX
}

struct Args {
    const float *x, *c, *ctx, *c_ctx, *w_mod, *b_mod, *w_in, *w_out, *s5_a_re, *s5_a_im, *s5_log_step, *s5_b_re, *s5_b_im, *s5_c_re, *s5_c_im, *s5_d, *s5_w_glu, *s5_b_glu,
        *q_norm_w, *k_norm_w, *conv_w, *w_router, *b_router, *w_gate_up, *b_gate_up, *w_down, *b_down;
    float* out; unsigned char* ws; int ph_lo, ph_hi, rep, pad;
};

__device__ __forceinline__ void p0_transpose_item(const float* W, int K, int N, bf16_t* WT, LAS float* scr, int item, int lane) {
    const int nblk = N / 32, kb = item / nblk, nb = item % nblk, k0 = 64 * kb, n0 = 32 * nb;
#pragma unroll 8
    for (int i = 0; i < 32; ++i) { const int kk = 2 * i + (lane >> 5); scr[kk * 33 + (lane & 31)] = W[(size_t)(k0 + kk) * N + n0 + (lane & 31)]; }
    asm volatile("s_waitcnt lgkmcnt(0)" ::: "memory");
    const int c = lane & 7;
#pragma unroll
    for (int j = 0; j < 4; ++j) { const int n = (lane >> 3) + 8 * j; const LAS float* s = scr + (8 * c) * 33 + n;
        u32x4 o; o.x = cvt_pk_bf16(s[0 * 33], s[1 * 33]); o.y = cvt_pk_bf16(s[2 * 33], s[3 * 33]); o.z = cvt_pk_bf16(s[4 * 33], s[5 * 33]); o.w = cvt_pk_bf16(s[6 * 33], s[7 * 33]);
        *(u32x4*)(WT + (size_t)(n0 + n) * K + k0 + 8 * c) = o; }
    asm volatile("s_waitcnt lgkmcnt(0)" ::: "memory");
}

__global__ void __launch_bounds__(512, 2) mega_fwd(Args a) {
    extern __shared__ __attribute__((aligned(16))) unsigned char lds_raw[];
    LAS unsigned char* lds = (LAS unsigned char*)lds_raw;
    const int G = gridDim.x, bx = blockIdx.x;
    const int NGW = G * 8, NGT = G * 512;
    const __attribute__((address_space(4))) Args* kargs = (const __attribute__((address_space(4))) Args*)__builtin_amdgcn_kernarg_segment_ptr();
#define KA(field) (kargs->field)
    unsigned char* const ws = KA(ws);
    unsigned* ctl = (unsigned*)(ws + WS_CTL);
#define MODP ((float*)(ws + WS_MODP))
#define MOD ((float*)(ws + WS_MOD))
#define WIN ((bf16_t*)(ws + WS_WIN))
#define WOUT ((bf16_t*)(ws + WS_WOUT))
#define WGLU ((bf16_t*)(ws + WS_WGLU))
#define WGU ((bf16_t*)(ws + WS_WGU))
#define WDN ((bf16_t*)(ws + WS_WDN))
#define WRT ((bf16_t*)(ws + WS_WRT))
#define KTAB ((float*)(ws + WS_KTAB))
#define WE ((bf16_t*)(ws + WS_WE))
#define WTC ((bf16_t*)(ws + WS_WTC))
#define APOW ((float*)(ws + WS_APOW))
#define XN ((bf16_t*)(ws + WS_XN))
#define Z ((bf16_t*)(ws + WS_Z))
#define UPX ((bf16_t*)(ws + WS_UPX))
#define EB ((float*)(ws + WS_E))
#define KVT ((float*)(ws + WS_KVT))
#define SPREV ((bf16_t*)(ws + WS_SPREV))
#define OP ((float*)(ws + WS_OP))
#define ML ((float*)(ws + WS_ML))
#define YG ((bf16_t*)(ws + WS_YG))
#define MIX ((bf16_t*)(ws + WS_MIX))
#define XA ((bf16_t*)(ws + WS_XA))
#define XB ((bf16_t*)(ws + WS_XB))
#define FB ((bf16_t*)(ws + WS_F))
#define LIST ((int*)(ws + WS_LIST))
#define TOKI ((int*)(ws + WS_TOKI))
#define GATE ((float*)(ws + WS_GATE))
#define HB ((bf16_t*)(ws + WS_H))
#define YB ((bf16_t*)(ws + WS_Y))

    if (threadIdx.x < 64) ((LAS unsigned*)(lds + LDSCTL_OFF))[threadIdx.x] = 0u;
    __syncthreads();
    XcdBarrier bar; bar.bar = ctl + CW_BAR; bar.x = 0; bar.st = (volatile LAS unsigned*)(lds + LDSCTL_OFF + LC_BAR);
    if (!MK_MULTI) bar = xcd_barrier_post(ctl + CW_BAR, (volatile LAS unsigned*)(lds + LDSCTL_OFF + LC_BAR));
    const int lo = KA(ph_lo), hi = KA(ph_hi);
#ifndef PHMASK
#define PHMASK 0xFFFF
#endif
#define PHEN(n) (((PHMASK) >> (n)) & 1)
#ifndef SUBMASK
#define SUBMASK 0xFFFF
#endif
#define SUB(n) if constexpr (((SUBMASK) >> (n)) & 1)
#define IN(k) (lo <= (k) && (k) < hi)
#define PHASE_IDS int bx_o = blockIdx.x, G_o = gridDim.x; asm volatile("" : "+s"(bx_o), "+s"(G_o)); const int bx = bx_o, G = G_o, NGW = G * 8, NGT = G * 512; (void)NGW; (void)NGT; const int tid = opaque_tid(); const int lane = tid & 63, wave = __builtin_amdgcn_readfirstlane(tid >> 6); const int gw = bx * 8 + wave, gt = bx * 512 + tid; (void)lane; (void)gw; (void)gt;
#define SEAM(k) do { if (IN(k) && IN((k) + 1)) xcd_barrier(bar); } while (0)

    if (PHEN(0) && IN(0)) { PHASE_IDS
        if (bx >= G / 2) {
            const int gt = (bx - G / 2) * 512 + tid, NGT = (G - G / 2) * 512, gw = (bx - G / 2) * 8 + wave, NGW = (G - G / 2) * 8; (void)gt; (void)NGT; (void)gw; (void)NGW;
        for (int i = gt; i < 2 * 32 * 2048; i += NGT) { const int l = i / 65536, r = i % 65536, e = r / 2048, k = r % 2048;
            const float w = KA(w_router)[(size_t)l * 65536 + k * 32 + e]; const unsigned h = f2bf(w); const float lo_ = w - bf2f(h);
            WRT[((size_t)(l * 2 + 0) * 32 + e) * 2048 + k] = (bf16_t)h; WRT[((size_t)(l * 2 + 1) * 32 + e) * 2048 + k] = (bf16_t)f2bf(lo_); }
        for (int it = gw; it < 2 * 32 * 48; it += NGW) { const int l = it / (32 * 48), r = it % (32 * 48), kc = r / 48, ng = r % 48;
            const float* W = KA(w_mod) + (size_t)l * D * 12288 + (size_t)(kc * 64) * 12288 + ng * 256 + lane * 4;
            f32x4 acc0 = {0.f, 0.f, 0.f, 0.f}, acc1 = {0.f, 0.f, 0.f, 0.f};
            const float cl = silu_(KA(c)[kc * 64 + lane]), cc = silu_(KA(c_ctx)[kc * 64 + lane]);
#pragma unroll 8
            for (int k = 0; k < 64; ++k) { const f32x4 w = *(const f32x4*)(W + (size_t)k * 12288); const float s0 = __shfl(cl, k), s1 = __shfl(cc, k); acc0 += w * s0; acc1 += w * s1; }
            float* o = MODP + (((size_t)kc * 2 + l) * 2) * 12288 + ng * 256 + lane * 4; *(f32x4*)o = acc0; *(f32x4*)(o + 12288) = acc1; }
        for (int i4 = gt; i4 < 2 * 32 * 2 * 256 * 4; i4 += NGT) { const int pq = i4 & 3, i = i4 >> 2; const int cp = i & 15, c = (i >> 4) & 15, d = (i >> 8) & 1, g = (i >> 9) & 31, l = i >> 14;
            float accv[32];
#pragma unroll
            for (int t = 0; t < 32; ++t) accv[t] = 0.f;
            const float step = __expf(KA(s5_log_step)[(l * 2 + d) * 32 + g]);
            float plre[16], plim[16], pbre[16], pbim[16], pcre[16], pcim[16];
#pragma unroll
            for (int q = 0; q < 16; ++q) { const int p = pq * 16 + q;
                plre[q] = KA(s5_a_re)[((l * 2 + d) * 32 + g) * 64 + p]; plim[q] = KA(s5_a_im)[((l * 2 + d) * 32 + g) * 64 + p];
                pbre[q] = KA(s5_b_re)[((l * 32 + g) * 64 + p) * 16 + cp]; pbim[q] = KA(s5_b_im)[((l * 32 + g) * 64 + p) * 16 + cp];
                pcre[q] = KA(s5_c_re)[((l * 32 + g) * 16 + c) * 64 + p]; pcim[q] = KA(s5_c_im)[((l * 32 + g) * 16 + c) * 64 + p]; }
#pragma unroll
            for (int q = 0; q < 16; ++q) {
                const float lre = plre[q], lim = plim[q];
                const float mag = __expf(lre * step); float sn, cs; sincos_ang(lim * step, sn, cs);
                const float are = mag * cs, aim = mag * sn, den = lre * lre + lim * lim, nre = are - 1.f;
                const float fre = (nre * lre + aim * lim) / den, fim = (aim * lre - nre * lim) / den;
                const float bre = pbre[q], bim = pbim[q], cre = pcre[q], cim = pcim[q];
                float tre = fre * bre - fim * bim, tim = fre * bim + fim * bre;
                float qre = cre * tre - cim * tim, qim = cre * tim + cim * tre;
#pragma unroll
                for (int t = 0; t < 32; ++t) { accv[t] += qre; const float nr = qre * are - qim * aim, ni = qre * aim + qim * are; qre = nr; qim = ni; }
            }
            float* o = KTAB + ((((size_t)(l * 32 + g) * 2 + d) * 32) * 256) + c * 16 + cp;
#pragma unroll
            for (int t = 0; t < 32; ++t) { float v = accv[t]; v += __shfl_xor(v, 1); v += __shfl_xor(v, 2); if (pq == 0) o[t * 256] = v; }
        }
        for (int i = gt; i < 2 * 32 * 2 * 64 * 16; i += NGT) { const int cp = i & 15, p = (i >> 4) & 63, d = (i >> 10) & 1, g = (i >> 11) & 31, l = i >> 16;
            const float step = __expf(KA(s5_log_step)[(l * 2 + d) * 32 + g]);
            const float lre = KA(s5_a_re)[((l * 2 + d) * 32 + g) * 64 + p], lim = KA(s5_a_im)[((l * 2 + d) * 32 + g) * 64 + p];
            float sn, cs; sincos_ang(lim * step, sn, cs); const float mag = __expf(lre * step);
            const float are = mag * cs, aim = mag * sn, den = lre * lre + lim * lim, nre = are - 1.f;
            const float fre = (nre * lre + aim * lim) / den, fim = (aim * lre - nre * lim) / den;
            const float bre = KA(s5_b_re)[((l * 32 + g) * 64 + p) * 16 + cp], bim = KA(s5_b_im)[((l * 32 + g) * 64 + p) * 16 + cp];
            float vre = fre * bre - fim * bim, vim = fre * bim + fim * bre;
            bf16_t* o = WE + (((size_t)(l * 32 + g) * 256) + d * 128 + p) * 512 + cp;
            float pre = 1.f, pim = 0.f;
#pragma unroll 8
            for (int j = 0; j < 32; ++j) { const int sx = d == 0 ? 31 - j : j; o[sx * 16] = (bf16_t)f2bf(vre); o[(size_t)64 * 512 + sx * 16] = (bf16_t)f2bf(vim);
                const float nr = vre * are - vim * aim, ni = vre * aim + vim * are; vre = nr; vim = ni;
                const float qr = pre * are - pim * aim, qi = pre * aim + pim * are; pre = qr; pim = qi; }
            if (cp == 0) { APOW[(((size_t)(l * 32 + g) * 2 + d) * 64 + p) * 2 + 0] = pre; APOW[(((size_t)(l * 32 + g) * 2 + d) * 64 + p) * 2 + 1] = pim; }
        }
        for (int i = gt; i < 2 * 32 * 2 * 16 * 64; i += NGT) { const int p = i & 63, c = (i >> 6) & 15, d = (i >> 10) & 1, g = (i >> 11) & 31, l = i >> 16;
            const float step = __expf(KA(s5_log_step)[(l * 2 + d) * 32 + g]);
            const float lre = KA(s5_a_re)[((l * 2 + d) * 32 + g) * 64 + p], lim = KA(s5_a_im)[((l * 2 + d) * 32 + g) * 64 + p];
            float sn, cs; sincos_ang(lim * step, sn, cs); const float mag = __expf(lre * step);
            const float are = mag * cs, aim = mag * sn;
            const float cre = KA(s5_c_re)[((l * 32 + g) * 16 + c) * 64 + p], cim = KA(s5_c_im)[((l * 32 + g) * 16 + c) * 64 + p];
            float gre = cre * are - cim * aim, gim = cre * aim + cim * are;
            bf16_t* o = WTC + (((size_t)(l * 32 + g) * 512) + c) * 768 + 512 + d * 128 + p;
#pragma unroll 8
            for (int m = 1; m <= 32; ++m) { const int t = d == 0 ? m - 1 : 32 - m; o[(size_t)t * 16 * 768] = (bf16_t)f2bf(gre); o[(size_t)t * 16 * 768 + 64] = (bf16_t)f2bf(-gim);
                const float nr = gre * are - gim * aim, ni = gre * aim + gim * are; gre = nr; gim = ni; }
        }
            }
        __syncthreads();
        {
            constexpr int T_GU = 16 * 32 * 8, T_DN = 0, T_IN = 2 * 32 * 22, T_OUT = 2 * 32 * 8, T_GLU = 2 * 8 * 2, NIT = T_GU + T_DN + T_IN + T_GLU;
            f32x4 cur[8], nxt[8];
            const float* src; bf16_t* dst; int Kd, Nd;
#define CV_DECODE(it, srcp, dstp, Kv, Nv) do { int r_ = (it); \
                if (r_ < T_GU) { const int b_ = r_ >> 8, q_ = r_ & 255; Kv = 2048; Nv = 2048; srcp = KA(w_gate_up) + (size_t)b_ * 2048 * 2048 + (size_t)(q_ >> 3) * 64 * 2048 + (q_ & 7) * 256; dstp = WGU + (size_t)b_ * 2048 * 2048 + (size_t)(q_ & 7) * 256 * 2048 + (q_ >> 3) * 64; } \
                else if ((r_ -= T_GU) < T_DN) { const int b_ = r_ >> 7, q_ = r_ & 127; Kv = 1024; Nv = 2048; srcp = KA(w_down) + (size_t)b_ * 1024 * 2048 + (size_t)(q_ >> 3) * 64 * 2048 + (q_ & 7) * 256; dstp = WDN + (size_t)b_ * 2048 * 1024 + (size_t)(q_ & 7) * 256 * 1024 + (q_ >> 3) * 64; } \
                else if ((r_ -= T_DN) < T_IN) { const int b_ = r_ / 704, q_ = r_ % 704; Kv = 2048; Nv = INC; srcp = KA(w_in) + (size_t)b_ * D * INC + (size_t)(q_ / 22) * 64 * INC + (q_ % 22) * 256; dstp = WIN + (size_t)b_ * INC * D + (size_t)(q_ % 22) * 256 * D + (q_ / 22) * 64; } \
                else if ((r_ -= T_IN) < 0) { } \
                else { const int b_ = r_ >> 4, q_ = r_ & 15; Kv = 512; Nv = 512; srcp = KA(s5_w_glu) + (size_t)b_ * 512 * 512 + (size_t)(q_ >> 1) * 64 * 512 + (q_ & 1) * 256; dstp = WGLU + (size_t)b_ * 512 * 512 + (size_t)(q_ & 1) * 256 * 512 + (q_ >> 1) * 64; } } while (0)
#define CV_LOAD(v, srcp, Nv) do { _Pragma("unroll") for (int j_ = 0; j_ < 4; ++j_) { v[2 * j_] = __builtin_nontemporal_load((const f32x4*)((srcp) + (size_t)(8 * wave + 2 * j_) * (Nv) + lane * 4)); v[2 * j_ + 1] = __builtin_nontemporal_load((const f32x4*)((srcp) + (size_t)(8 * wave + 2 * j_ + 1) * (Nv) + lane * 4)); } } while (0)
            LAS int* qw = (LAS int*)(lds + LDSCTL_OFF + 1024);
            unsigned* qctr = (unsigned*)(ws + WS_CTL) + CW_QB;
            if (tid == 0) { qw[0] = T_GU + T_DN + (int)atomicAdd(qctr, 1u); qw[1] = T_GU + T_DN + (int)atomicAdd(qctr, 1u); }
            __syncthreads();
            int it = qw[0], nit = qw[1];
            if (it < NIT) { CV_DECODE(it, src, dst, Kd, Nd); CV_LOAD(cur, src, Nd); }
            while (it < NIT) {
                const float* nsrc = src; bf16_t* ndst = dst; int nK = Kd, nN = Nd;
                if (nit < NIT) { CV_DECODE(nit, nsrc, ndst, nK, nN); CV_LOAD(nxt, nsrc, nN); }
                int qn = 0; if (tid == 0) qn = T_GU + T_DN + (int)atomicAdd(qctr, 1u);
#pragma unroll
                for (int j = 0; j < 4; ++j)
#pragma unroll
                    for (int e = 0; e < 4; ++e) *(LAS unsigned*)(lds + ((4 * lane + e) * 32 + ((4 * wave + j + lane) & 31)) * 4) = cvt_pk_bf16(cur[2 * j][e], cur[2 * j + 1][e]);
                __syncthreads();
#pragma unroll
                for (int q = 0; q < 4; ++q) { const int n = q * 64 + (tid >> 3), c = tid & 7; u32x4 w;
                    w.x = *(const LAS unsigned*)(lds + (n * 32 + ((4 * c + 0 + (n >> 2)) & 31)) * 4); w.y = *(const LAS unsigned*)(lds + (n * 32 + ((4 * c + 1 + (n >> 2)) & 31)) * 4);
                    w.z = *(const LAS unsigned*)(lds + (n * 32 + ((4 * c + 2 + (n >> 2)) & 31)) * 4); w.w = *(const LAS unsigned*)(lds + (n * 32 + ((4 * c + 3 + (n >> 2)) & 31)) * 4);
                    *(u32x4*)(dst + (size_t)n * Kd + c * 8) = w; }
                if (tid == 0) qw[2] = qn;
                __syncthreads();
#pragma unroll
                for (int j = 0; j < 8; ++j) cur[j] = nxt[j];
                src = nsrc; dst = ndst; Kd = nK; Nd = nN; it = nit; nit = qw[2];
            }
            __syncthreads();
            {
                constexpr int NIT8 = T_GU + T_DN + T_OUT;
#define CV8_DECODE(it8, srcp, dstp, Kv) do { int r_ = (it8); \
                    if (r_ < T_GU) { const int b_ = r_ >> 8, q_ = r_ & 255; Kv = 2048; srcp = KA(w_gate_up) + (size_t)b_ * 2048 * 2048 + (size_t)(q_ >> 3) * 64 * 2048 + (q_ & 7) * 256; dstp = (unsigned char*)WGU + (size_t)b_ * 2048 * 2048 + (size_t)(q_ & 7) * 256 * 2048 + (q_ >> 3) * 64; } \
                    else { r_ -= T_GU + T_DN; const int b_ = r_ >> 8, q_ = r_ & 255, kt_ = q_ >> 3, kn_ = kt_ < 8 ? kt_ : (kt_ < 16 ? kt_ + 16 : kt_ - 8); Kv = 2048; srcp = KA(w_out) + (size_t)b_ * D * D + (size_t)kt_ * 64 * 2048 + (q_ & 7) * 256; dstp = (unsigned char*)WOUT + (size_t)b_ * D * D + (size_t)(q_ & 7) * 256 * 2048 + kn_ * 64; } } while (0)
#define CV8_LOAD(v, srcp) do { _Pragma("unroll") for (int j_ = 0; j_ < 8; ++j_) v[j_] = __builtin_nontemporal_load((const f32x4*)((srcp) + (size_t)(8 * wave + j_) * 2048 + lane * 4)); } while (0)
                const float* src8; unsigned char* dst8; int K8;
                unsigned* qctr8 = (unsigned*)(ws + WS_CTL) + CW_Q8;
                if (tid == 0) { qw[0] = (int)atomicAdd(qctr8, 1u); qw[1] = (int)atomicAdd(qctr8, 1u); }
                __syncthreads();
                int it8 = qw[0], nit8 = qw[1];
                if (it8 < NIT8) { CV8_DECODE(it8, src8, dst8, K8); CV8_LOAD(cur, src8); }
                while (it8 < NIT8) {
                    const float* nsrc = src8; unsigned char* ndst = dst8; int nK = K8;
                    if (nit8 < NIT8) { CV8_DECODE(nit8, nsrc, ndst, nK); CV8_LOAD(nxt, nsrc); }
                    int qn = 0; if (tid == 0) qn = (int)atomicAdd(qctr8, 1u);
#pragma unroll
                    for (int j = 0; j < 2; ++j)
#pragma unroll
                        for (int e = 0; e < 4; ++e) *(LAS unsigned*)(lds + ((4 * lane + e) * 16 + ((2 * wave + j + lane) & 15)) * 4) =
                            pk4_fp8(cur[4 * j][e] * W8_SCALE, cur[4 * j + 1][e] * W8_SCALE, cur[4 * j + 2][e] * W8_SCALE, cur[4 * j + 3][e] * W8_SCALE);
                    __syncthreads();
#pragma unroll
                    for (int q = 0; q < 2; ++q) { const int id = q * 512 + tid, n = id >> 2, c = id & 3; u32x4 w;
                        w.x = *(const LAS unsigned*)(lds + (n * 16 + ((4 * c + 0 + (n >> 2)) & 15)) * 4); w.y = *(const LAS unsigned*)(lds + (n * 16 + ((4 * c + 1 + (n >> 2)) & 15)) * 4);
                        w.z = *(const LAS unsigned*)(lds + (n * 16 + ((4 * c + 2 + (n >> 2)) & 15)) * 4); w.w = *(const LAS unsigned*)(lds + (n * 16 + ((4 * c + 3 + (n >> 2)) & 15)) * 4);
                        *(u32x4*)(dst8 + (size_t)n * K8 + c * 16) = w; }
                    if (tid == 0) qw[2] = qn;
                    __syncthreads();
#pragma unroll
                    for (int j = 0; j < 8; ++j) cur[j] = nxt[j];
                    src8 = nsrc; dst8 = ndst; K8 = nK; it8 = nit8; nit8 = qw[2];
                }
#undef CV8_DECODE
#undef CV8_LOAD
            }
#undef CV_DECODE
#undef CV_LOAD
        }
    }
    SEAM(0);
    if (PHEN(1) && IN(1)) { PHASE_IDS
        for (int i = gt; i < 2 * 2 * 12288; i += NGT) { const int l = i / 24576, n = i % 12288; float s = KA(b_mod)[l * 12288 + n];
            for (int kc = 0; kc < 32; ++kc) s += MODP[(size_t)kc * 2 * 2 * 12288 + i]; MOD[i] = s; }
        for (int i = gt; i < 2 * 32 * 512 * 64; i += NGT) { const int k8 = i & 63, n = (i >> 6) & 511, g = (i >> 15) & 31, l = i >> 20;
            const int t = n >> 4, c = n & 15, s = k8 >> 1, cp0 = (k8 & 1) * 8; float v[8];
#pragma unroll
            for (int e = 0; e < 8; ++e) v[e] = 0.f;
            const float* kt = KTAB + ((size_t)(l * 32 + g) * 2) * 32 * 256;
            if (s <= t) { const float* p = kt + (0 * 32 + (t - s)) * 256 + c * 16 + cp0; const f32x4 a0 = *(const f32x4*)p, a1 = *(const f32x4*)(p + 4);
#pragma unroll
                for (int e = 0; e < 4; ++e) { v[e] += a0[e]; v[4 + e] += a1[e]; } }
            if (s >= t) { const float* p = kt + (1 * 32 + (s - t)) * 256 + c * 16 + cp0; const f32x4 a0 = *(const f32x4*)p, a1 = *(const f32x4*)(p + 4);
#pragma unroll
                for (int e = 0; e < 4; ++e) { v[e] += a0[e]; v[4 + e] += a1[e]; } }
            if (s == t) { const float dd = KA(s5_d)[l * 512 + g * 16 + c];
#pragma unroll
                for (int e = 0; e < 8; ++e) v[e] += (cp0 + e == c) ? dd : 0.f; }
            u32x4 w; w.x = cvt_pk_bf16(v[0], v[1]); w.y = cvt_pk_bf16(v[2], v[3]); w.z = cvt_pk_bf16(v[4], v[5]); w.w = cvt_pk_bf16(v[6], v[7]);
            *(u32x4*)(WTC + (((size_t)(l * 32 + g) * 512) + n) * 768 + k8 * 8) = w; }
    }
    SEAM(1);
    if (PHEN(2) && IN(2)) { PHASE_IDS
        for (int r = gw; r < ROWS; r += NGW) {
            const float* xr = (r < CTXL) ? KA(ctx) + (size_t)r * D : KA(x) + (size_t)(r - CTXL) * D; const float* md = MOD + (r < CTXL ? 12288 : 0);
            f32x4 v[8], sh[8], sc[8]; float ss = 0.f;
#pragma unroll
            for (int j = 0; j < 8; ++j) v[j] = *(const f32x4*)(xr + lane * 4 + 256 * j);
#pragma unroll
            for (int j = 0; j < 8; ++j) { const int c = lane * 4 + 256 * j; sh[j] = *(const f32x4*)(md + c); sc[j] = *(const f32x4*)(md + 2048 + c); }
#pragma unroll
            for (int j = 0; j < 8; ++j) ss += v[j][0] * v[j][0] + v[j][1] * v[j][1] + v[j][2] * v[j][2] + v[j][3] * v[j][3];
            const float rstd = __builtin_amdgcn_rsqf(wave_sum(ss) * (1.f / D) + EPS);
#pragma unroll
            for (int j = 0; j < 8; ++j) { const int c = lane * 4 + 256 * j;
                const f32x4 o = v[j] * rstd * (sc[j] + 1.f) + sh[j]; u32x2 w; w.x = cvt_pk_bf16(o[0], o[1]); w.y = cvt_pk_bf16(o[2], o[3]); *(u32x2*)(XN + (size_t)r * D + c) = w; }
        }
    }
    SEAM(2);

    for (int l = 0; l < NL; ++l) {
        const int pb = 3 + 10 * l;
        const float* MODL = MOD + (size_t)l * 2 * 12288;
        const float* xin_c = KA(ctx);
        const float* xin_l = KA(x) - (size_t)CTXL * D;
        const bf16_t* xin_b = (l == 0) ? (const bf16_t*)nullptr : (const bf16_t*)XB;
#define CNT ((unsigned*)(ws + WS_CTL) + CW_CNT + l * 2048)
        if (PHEN(3) && IN(pb + 0)) { PHASE_IDS
            pg8::DenseSched S; S.init(XN, D, ROWS / 256, WIN + (size_t)l * INC * D, D, INC / 256, G, bx);
            EpiInProj E{Z, UPX};
            pg8::gemm_phase<EpiInProj, pg8::DenseSched, false>(lds, D, D, D, S, E);
        }
        SEAM(pb + 0);
        if (PHEN(4) && IN(pb + 1)) { PHASE_IDS
            SUB(0) for (int r = gw; r < ROWS; r += NGW) {
                const int hs = lane >> 4, sub = lane & 15, half = sub >> 3, j0 = (sub & 7) * 4, d1 = half * 64 + j0;
#pragma unroll
                for (int part = 0; part < 2; ++part) {
                    const int hd = part == 0 ? hs : (hs & 1); const bool act = part == 0 || hs < 2;
                    bf16_t* zp = Z + (size_t)r * INC + (part == 0 ? ZC_AQ : ZC_AK) + hd * 128 + d1;
                    const s16x4 a1 = *(const s16x4*)zp, a2 = *(const s16x4*)(zp + 32);
                    float x1[4], x2[4], ss = 0.f;
#pragma unroll
                    for (int e = 0; e < 4; ++e) { x1[e] = bfs2f(a1[e]); x2[e] = bfs2f(a2[e]); ss += x1[e] * x1[e] + x2[e] * x2[e]; }
                    ss += __shfl_xor(ss, 1); ss += __shfl_xor(ss, 2); ss += __shfl_xor(ss, 4); ss += __shfl_xor(ss, 8);
                    const float rstd = __builtin_amdgcn_rsqf(ss * (1.f / 128.f) + EPS);
                    const float* nw = (part == 0 ? KA(q_norm_w) : KA(k_norm_w)) + l * 128 + d1;
                    const f32x4 w1 = *(const f32x4*)nw, w2 = *(const f32x4*)(nw + 32);
#pragma unroll
                    for (int e = 0; e < 4; ++e) { x1[e] = x1[e] * rstd * w1[e]; x2[e] = x2[e] * rstd * w2[e]; }
                    if (r >= CTXL) { const int t = r - CTXL; const float pos = (float)(half ? (t & 63) : (t >> 6));
#pragma unroll
                        for (int e = 0; e < 4; ++e) { const float freq = __builtin_amdgcn_exp2f(-(float)(j0 + e) * (LOG2_1E4 / 32.f)); float sn, cs; sincos_ang(pos * freq, sn, cs);
                            const float y1 = x1[e] * cs - x2[e] * sn, y2 = x1[e] * sn + x2[e] * cs; x1[e] = y1; x2[e] = y2; } }
                    if (act && !KA(rep)) { u32x2 w; w.x = cvt_pk_bf16(x1[0], x1[1]); w.y = cvt_pk_bf16(x1[2], x1[3]); *(u32x2*)zp = w; w.x = cvt_pk_bf16(x2[0], x2[1]); w.y = cvt_pk_bf16(x2[2], x2[3]); *(u32x2*)(zp + 32) = w; }
                }
            }
            SUB(1) for (int it = gt; it < ROWS * 64; it += NGT) { const int r = it >> 6, c = (it & 63) * 8; const bf16_t* zr = Z + (size_t)r * INC;
                const bool hasp = (r != 0 && r != CTXL), hasn = (r != CTXL - 1 && r != ROWS - 1);
                const bf16x8 bg = *(const bf16x8*)(zr + ZC_CB + c), c0 = *(const bf16x8*)(zr + ZC_CC + c), h0 = *(const bf16x8*)(zr + ZC_CH + c);
                bf16x8 cm = {}, hm = {}, cp_ = {}, hp = {};
                if (hasp) { cm = *(const bf16x8*)(zr - INC + ZC_CC + c); hm = *(const bf16x8*)(zr - INC + ZC_CH + c); }
                if (hasn) { cp_ = *(const bf16x8*)(zr + INC + ZC_CC + c); hp = *(const bf16x8*)(zr + INC + ZC_CH + c); }
                const float* cw = KA(conv_w) + (size_t)l * 3 * 512 + c; float o[8];
#pragma unroll
                for (int e = 0; e < 8; ++e) o[e] = bfs2f(bg[e]) * (cw[e] * bfs2f(cm[e]) * bfs2f(hm[e]) + cw[512 + e] * bfs2f(c0[e]) * bfs2f(h0[e]) + cw[1024 + e] * bfs2f(cp_[e]) * bfs2f(hp[e]));
                u32x2 w; w.x = pk4_fp8(o[0], o[1], o[2], o[3]); w.y = pk4_fp8(o[4], o[5], o[6], o[7]);
                *(u32x2*)((unsigned char*)MIX + (size_t)r * D + 1024 + c) = w; }
            asm volatile("s_waitcnt vmcnt(0)" ::: "memory"); __syncthreads();
            SUB(2) {
                pg8::BatchSched S; S.A = (const char*)UPX; S.B = (const char*)(WE + (size_t)l * 32 * 256 * 512); S.sA = (size_t)512 * 768 * 2; S.sB = (size_t)256 * 512 * 2; S.lda = 768; S.ldb = 512; S.nM = 2; S.nN = 1; S.nb = 32; S.G = G; S.c = bx;
                EpiS1 E{EB};
                pg8::gemm_phase<EpiS1, pg8::BatchSched, false>(lds, 768, 512, 512, S, E);
            }
            __syncthreads();
            SUB(3) for (int u = (G > 64 ? bx - 64 : bx); u >= 0 && u < NBLK * 4; u += (G > 64 ? G - 64 : G)) {
                const int b = u >> 2, h = u & 3, fr = lane & 15, fq = lane >> 4;
                LAS unsigned char* VT = lds; LAS unsigned char* KF = lds + 34816; LAS unsigned char* KBk = lds + 69632;
                const float l2gf = log2f(1.f - __builtin_amdgcn_exp2f(-5.f - (float)h)), l2gb = log2f(1.f - __builtin_amdgcn_exp2f(-5.f - (float)(3 - h)));
                {
                    const int j = tid >> 2, sub = tid & 3, row = b * 128 + j; const bf16_t* zr = Z + (size_t)row * INC;
                    const float wf = __builtin_amdgcn_exp2f(l2gf * (float)(127 - j)) * 0.08838834764831845f, wb = __builtin_amdgcn_exp2f(l2gb * (float)j) * 0.08838834764831845f;
                    const bool lat = row >= CTXL; const float tpos = (float)(row - CTXL);
#pragma unroll
                    for (int h8 = 0; h8 < 2; ++h8) { const int dk0 = 16 * sub + 8 * h8;
                        const bf16x8 k1 = *(const bf16x8*)(zr + ZC_RK + h * 128 + dk0), k2 = *(const bf16x8*)(zr + ZC_RK + h * 128 + 64 + dk0);
#pragma unroll
                        for (int e = 0; e < 8; ++e) { const int dk = dk0 + e; float y1 = bfs2f(k1[e]), y2 = bfs2f(k2[e]);
                            if (lat) { const float freq = __builtin_amdgcn_exp2f(-(float)dk * (LOG2_1E4 / 64.f)); float sn, cs; sincos_ang(tpos * freq, sn, cs); const float t1 = y1 * cs - y2 * sn, t2 = y1 * sn + y2 * cs; y1 = t1; y2 = t2; }
                            *(LAS bf16_t*)(KF + dk * 272 + j * 2) = (bf16_t)f2bf(y1 * wf); *(LAS bf16_t*)(KF + (dk + 64) * 272 + j * 2) = (bf16_t)f2bf(y2 * wf);
                            *(LAS bf16_t*)(KBk + dk * 272 + j * 2) = (bf16_t)f2bf(y1 * wb); *(LAS bf16_t*)(KBk + (dk + 64) * 272 + j * 2) = (bf16_t)f2bf(y2 * wb); } }
#pragma unroll
                    for (int q = 0; q < 4; ++q) { const bf16x8 v = *(const bf16x8*)(zr + ZC_RV + h * 128 + 32 * sub + 8 * q);
#pragma unroll
                        for (int e = 0; e < 8; ++e) *(LAS bf16_t*)(VT + (32 * sub + 8 * q + e) * 272 + j * 2) = (bf16_t)v[e]; }
                }
                __syncthreads();
                f32x4 af[8], ab[8];
#pragma unroll
                for (int n = 0; n < 8; ++n) { af[n] = (f32x4){0.f, 0.f, 0.f, 0.f}; ab[n] = (f32x4){0.f, 0.f, 0.f, 0.f}; }
#pragma unroll
                for (int k0 = 0; k0 < 128; k0 += 32) { const bf16x8 av = *(const LAS bf16x8*)(VT + (16 * wave + fr) * 272 + (k0 + fq * 8) * 2);
#pragma unroll
                    for (int n = 0; n < 8; ++n) { const bf16x8 bfv = *(const LAS bf16x8*)(KF + (16 * n + fr) * 272 + (k0 + fq * 8) * 2), bbv = *(const LAS bf16x8*)(KBk + (16 * n + fr) * 272 + (k0 + fq * 8) * 2);
                        af[n] = MFMA16(bfv, av, af[n]); ab[n] = MFMA16(bbv, av, ab[n]); } }
                float* of = KVT + ((size_t)(b * 4 + h) * 2) * 16384 + (16 * wave + fr) * 128 + 4 * fq;
#pragma unroll
                for (int n = 0; n < 8; ++n) { *(f32x4*)(of + 16 * n) = af[n]; *(f32x4*)(of + 16384 + 16 * n) = ab[n]; }
                __syncthreads();
            }
        }
        SEAM(pb + 1);
        if (PHEN(5) && IN(pb + 2)) { PHASE_IDS
            for (int idx = gt; idx < 8 * 16384; idx += NGT) { const int hd = idx >> 14, e = idx & 16383, h = hd >> 1, d = hd & 1;
                const float gam = 1.f - __builtin_amdgcn_exp2f(-5.f - (float)(d ? 3 - h : h)); const float g128 = __builtin_amdgcn_exp2f(128.f * log2f(gam)); float st = 0.f;
                for (int s0 = 0; s0 < NBLK; s0 += 33) { float kv[33];
#pragma unroll
                    for (int q = 0; q < 33; ++q) { const int s = s0 + q; const int b = d == 0 ? s : (s < 2 ? 1 - s : 67 - s); kv[q] = KVT[((size_t)(b * 4 + h) * 2 + d) * 16384 + e]; }
#pragma unroll
                    for (int q = 0; q < 33; ++q) { const int s = s0 + q; const int b = d == 0 ? s : (s < 2 ? 1 - s : 67 - s); SPREV[((size_t)(b * 4 + h) * 2 + d) * 16384 + e] = (bf16_t)f2bf(st); st = st * g128 + kv[q]; } } }
            for (int gd = G - 1 - bx; gd < 64; gd += G) { const int g = gd >> 1, d = gd & 1, seg = tid >> 6, p = tid & 63;
                const float are = APOW[(((size_t)(l * 32 + g) * 2 + d) * 64 + p) * 2 + 0], aim = APOW[(((size_t)(l * 32 + g) * 2 + d) * 64 + p) * 2 + 1];
                const float* Eg = EB + (size_t)g * 512 * 256 + d * 128 + p; bf16_t* Xg = UPX + (size_t)g * 512 * 768 + 512 + d * 128 + p;
                LAS float* ex = (LAS float*)lds;
                float er[33], ei[33];
#pragma unroll
                for (int q = 0; q < 33; ++q) { const int s_ = seg * 33 + q; const int j = d == 0 ? s_ : (s_ < 8 ? 7 - s_ : 271 - s_); er[q] = Eg[(size_t)j * 256]; ei[q] = Eg[(size_t)j * 256 + 64]; }
                float sre = 0.f, sim = 0.f;
#pragma unroll
                for (int q = 0; q < 33; ++q) { const float e_r = er[q], e_i = ei[q]; er[q] = sre; ei[q] = sim; const float nr = are * sre - aim * sim + e_r, ni = are * sim + aim * sre + e_i; sre = nr; sim = ni; }
                ex[(seg * 64 + p) * 2] = sre; ex[(seg * 64 + p) * 2 + 1] = sim;
                float pr = 1.f, pi = 0.f;
#pragma unroll
                for (int q = 0; q < 33; ++q) { const float nr = pr * are - pi * aim, ni = pr * aim + pi * are; pr = nr; pi = ni; }
                __syncthreads();
                float cre = 0.f, cim = 0.f;
                for (int s2 = 0; s2 < seg; ++s2) { const float e_r = ex[(s2 * 64 + p) * 2], e_i = ex[(s2 * 64 + p) * 2 + 1]; const float nr = pr * cre - pi * cim + e_r, ni = pr * cim + pi * cre + e_i; cre = nr; cim = ni; }
#pragma unroll
                for (int q = 0; q < 33; ++q) { const int s_ = seg * 33 + q; const int j = d == 0 ? s_ : (s_ < 8 ? 7 - s_ : 271 - s_);
                    Xg[(size_t)j * 768] = (bf16_t)f2bf(er[q] + cre); Xg[(size_t)j * 768 + 64] = (bf16_t)f2bf(ei[q] + cim);
                    const float nr = are * cre - aim * cim, ni = are * cim + aim * cre; cre = nr; cim = ni; }
                __syncthreads();
            }
            __syncthreads();
            for (int u = bx; u < 256 + (l == 0 ? 4 : 0); u += G) {
                if (u < 256) { const int half = u & 1, h = (u >> 1) & 3, qb = u >> 3; const int r0 = CTXL + qb * 256, k0 = half * (ROWS / 2);
                    unsigned* pcur = (unsigned*)(ws + WS_CTL) + CW_PG + bx; const int c0 = (int)__builtin_amdgcn_readfirstlane((int)__hip_atomic_load(pcur, __ATOMIC_RELAXED, __HIP_MEMORY_SCOPE_AGENT));
                    const PgA PG{KA(w_gate_up), KA(w_down), (unsigned char*)WGU, (unsigned char*)WDN, bx, c0};
                    att::attn_dense_body<true>(Z + (size_t)r0 * INC + ZC_AQ + h * 128, Z + (size_t)k0 * INC + ZC_AK + (h >> 1) * 128, Z + (size_t)k0 * INC + ZC_AV + (h >> 1) * 128,
                                         OP + ((size_t)half * ROWS + r0) * 512 + h * 128, ML + (((size_t)half * ROWS + r0) * 4 + h) * 2, ROWS / 2, (char*)lds_raw, PG);
                    if (tid == 0) { const int nc = c0 + 4 * PGA_NI; __hip_atomic_store(pcur, (unsigned)(nc > PGA_IPB ? PGA_IPB : nc), __ATOMIC_RELAXED, __HIP_MEMORY_SCOPE_AGENT); } }
                else { const int h = u - 256;
                    att::attn_dense_body<false>(Z + ZC_AQ + h * 128, Z + ZC_AK + (h >> 1) * 128, Z + ZC_AV + (h >> 1) * 128, OP + h * 128, ML + h * 2, CTXL, (char*)lds_raw); }
            }
        }
        SEAM(pb + 2);
        if (PHEN(6) && IN(pb + 3)) { PHASE_IDS
            SUB(4) for (int it = gt; it < ROWS * 4 * 32; it += NGT) { const int q4 = it & 31, h = (it >> 5) & 3, r = it >> 7; if (l == 1 && r < CTXL) continue;
                const float C = att::SCALE * 1.4426950408889634f;
                const f32x4 o0 = *(const f32x4*)(OP + (size_t)r * 512 + h * 128 + q4 * 4); f32x4 o = o0;
                if (r >= CTXL) { const float m0 = ML[((size_t)r * 4 + h) * 2], l0 = ML[((size_t)r * 4 + h) * 2 + 1], m1 = ML[(((size_t)ROWS + r) * 4 + h) * 2], l1 = ML[(((size_t)ROWS + r) * 4 + h) * 2 + 1];
                    const f32x4 o1 = *(const f32x4*)(OP + ((size_t)ROWS + r) * 512 + h * 128 + q4 * 4); const float mm = fmaxf(m0, m1);
                    const float w0 = l0 * __builtin_amdgcn_exp2f((m0 - mm) * C), w1 = l1 * __builtin_amdgcn_exp2f((m1 - mm) * C); const float inv = __builtin_amdgcn_rcpf(w0 + w1); o = (o0 * w0 + o1 * w1) * inv; }
                *(unsigned*)((unsigned char*)MIX + (size_t)r * D + 512 + h * 128 + q4 * 4) = pk4_fp8(o[0], o[1], o[2], o[3]); }
            asm volatile("s_waitcnt vmcnt(0)" ::: "memory"); __syncthreads();
            SUB(5) {
                pg8::BatchSched S; S.A = (const char*)UPX; S.B = (const char*)(WTC + (size_t)l * 32 * 512 * 768); S.sA = (size_t)512 * 768 * 2; S.sB = (size_t)512 * 768 * 2; S.lda = 768; S.ldb = 768; S.nM = 2; S.nN = 2; S.nb = 32; S.G = G; S.c = bx;
                EpiS3 E{YG};
                pg8::gemm_phase<EpiS3, pg8::BatchSched, false>(lds, 768, 768, 768, S, E);
            }
            __syncthreads();
            if (bx >= G / 2) { const int nup = G - G / 2, j = bx - G / 2, nreg = (l == 0) ? (nup >= 8 ? nup - 8 : 0) : nup;
                if (j < nreg) ret_out_unit(lds, ws, (8 + j) >> 2, (8 + j) & 3);
                else if (l == 0) for (int u = j - nreg; u < 8; u += nup) ret_out_unit(lds, ws, u >> 2, u & 3); }
        }
        SEAM(pb + 3);
        if (PHEN(7) && IN(pb + 4)) { PHASE_IDS
            {
                pg8::DenseSched S; S.init(YG, 512, ROWS / 256, WGLU + (size_t)l * 512 * 512, 512, 2, G, bx);
                EpiGLU E{YG, (unsigned char*)MIX, KA(s5_b_glu) + l * 512};
                pg8::gemm_phase<EpiGLU, pg8::DenseSched, false>(lds, 512, 512, 512, S, E);
            }
            int r3_off = 66;
            if (l == 0) {
                pg8::DenseSched S; S.init(MIX, D / 2, 1, (const unsigned char*)WOUT + (size_t)l * D * D, D / 2, D / 256, G, (bx + G - 66) % G);
                EpiOut E{xin_c, xin_l, xin_b, XA, MODL, 0, 0};
                pg8::gemm_phase<EpiOut, pg8::DenseSched, false, true>(lds, D / 2, D / 2, 768, S, E);
                r3_off = 74;
            }
            __syncthreads();
            { const int nup = G - G / 2, nreg = (l == 0) ? (nup >= 8 ? nup - 8 : 0) : nup;
                for (int u = 8 + nreg + (bx + G - (r3_off % G)) % G; u < NBLK * 4; u += G) ret_out_unit(lds, ws, u >> 2, u & 3); }
                }
        SEAM(pb + 4);
        if (PHEN(8) && IN(pb + 5)) { PHASE_IDS
            {
                pg8::DenseSched S; S.init((const unsigned char*)MIX + (size_t)CTXL * D, D / 2, SEQ / 256, (const unsigned char*)WOUT + (size_t)l * D * D, D / 2, D / 256, G, bx);
                EpiOut E{xin_c, xin_l, xin_b, XA, MODL, CTXL, 0};
                pg8::gemm_phase<EpiOut, pg8::DenseSched, false, true>(lds, D / 2, D / 2, D / 2, S, E);
            }
            if (l == 0) {
                pg8::DenseSched S; S.init((const unsigned char*)MIX + 1536, D / 2, 1, (const unsigned char*)WOUT + (size_t)l * D * D + 1536, D / 2, D / 256, G, bx);
                EpiOut E{xin_c, xin_l, xin_b, XA, MODL, 0, 1};
                pg8::gemm_phase<EpiOut, pg8::DenseSched, false, true>(lds, D / 2, D / 2, 256, S, E);
            }
        }
        SEAM(pb + 5);
        if (PHEN(9) && IN(pb + 6)) { PHASE_IDS
            if (l == NL - 1) {
                unsigned* pcur = (unsigned*)(ws + WS_CTL) + CW_PG + bx; const int c0 = (int)__builtin_amdgcn_readfirstlane((int)__hip_atomic_load(pcur, __ATOMIC_RELAXED, __HIP_MEMORY_SCOPE_AGENT));
                const PgA PG{KA(w_gate_up), KA(w_down), (unsigned char*)WGU, (unsigned char*)WDN, bx, c0};
                const int nst = (PGA_IPB - c0 + 3) / 4;
                for (int st = 0; st < nst + 2; ++st) { pga_rb(PG, lds, st, nst, wave); asm volatile("s_waitcnt vmcnt(0) lgkmcnt(0)" ::: "memory"); __syncthreads();
                    pga_ci(PG, lds, st, nst, wave); asm volatile("s_waitcnt vmcnt(0) lgkmcnt(0)" ::: "memory"); __syncthreads(); }
            }
            const int rbeg = (l == NL - 1) ? CTXL : 0; const int npair = (ROWS - rbeg) / 32; const int fr = lane & 15, fq = lane >> 4;
            const int tsk = wave >> 2, kq = wave & 3;
            LAS float* ssp = (LAS float*)(lds + 32768);
            LAS float* lgp = (LAS float*)lds;
            for (int pair = bx; pair < npair; pair += G) {
                const int r = rbeg + (pair * 2 + tsk) * 16 + fr; const bf16_t* xr = XA + (size_t)r * D + kq * 512 + fq * 8; const float* md = MODL + (r < CTXL ? 12288 : 0) + 3 * 2048 + kq * 512 + fq * 8;
                float ss = 0.f;
#pragma unroll
                for (int s = 0; s < 16; ++s) { f32x4 v0, v1; ld8_bf16(xr + 32 * s, v0, v1);
                    ss += (v0[0] * v0[0] + v0[1] * v0[1]) + (v0[2] * v0[2] + v0[3] * v0[3]) + (v1[0] * v1[0] + v1[1] * v1[1]) + (v1[2] * v1[2] + v1[3] * v1[3]); }
                ss += __shfl_xor(ss, 16); ss += __shfl_xor(ss, 32);
                if (fq == 0) ssp[(tsk * 4 + kq) * 16 + fr] = ss;
                __syncthreads();
                const float rstd = __builtin_amdgcn_rsqf(((ssp[(tsk * 4 + 0) * 16 + fr] + ssp[(tsk * 4 + 1) * 16 + fr]) + (ssp[(tsk * 4 + 2) * 16 + fr] + ssp[(tsk * 4 + 3) * 16 + fr])) * (1.f / D) + EPS);
                f32x4 acc0 = {0.f, 0.f, 0.f, 0.f}, acc1 = {0.f, 0.f, 0.f, 0.f};
                const bf16_t* wh = WRT + ((size_t)(l * 2 + 0) * 32 + fr) * 2048 + kq * 512 + fq * 8; const bf16_t* wl = WRT + ((size_t)(l * 2 + 1) * 32 + fr) * 2048 + kq * 512 + fq * 8;
#pragma unroll 4
                for (int s = 0; s < 16; ++s) { f32x4 v0, v1; ld8_bf16(xr + 32 * s, v0, v1);
                    const f32x4 sh0 = *(const f32x4*)(md + 32 * s), sh1 = *(const f32x4*)(md + 32 * s + 4), sc0 = *(const f32x4*)(md + 2048 + 32 * s), sc1 = *(const f32x4*)(md + 2048 + 32 * s + 4);
                    const f32x4 f0 = v0 * rstd * (sc0 + 1.f) + sh0, f1 = v1 * rstd * (sc1 + 1.f) + sh1;
                    u32x4 hw; hw.x = cvt_pk_bf16(f0[0], f0[1]); hw.y = cvt_pk_bf16(f0[2], f0[3]); hw.z = cvt_pk_bf16(f1[0], f1[1]); hw.w = cvt_pk_bf16(f1[2], f1[3]);
                    { u32x2 f8; f8.x = pk4_fp8(f0[0], f0[1], f0[2], f0[3]); f8.y = pk4_fp8(f1[0], f1[1], f1[2], f1[3]); *(u32x2*)((unsigned char*)FB + (size_t)r * D + kq * 512 + 32 * s + fq * 8) = f8; }
                    u32x4 lw; lw.x = cvt_pk_bf16(f0[0] - bf2f(hw.x), f0[1] - bf2f(hw.x >> 16)); lw.y = cvt_pk_bf16(f0[2] - bf2f(hw.y), f0[3] - bf2f(hw.y >> 16));
                    lw.z = cvt_pk_bf16(f1[0] - bf2f(hw.z), f1[1] - bf2f(hw.z >> 16)); lw.w = cvt_pk_bf16(f1[2] - bf2f(hw.w), f1[3] - bf2f(hw.w >> 16));
                    const bf16x8 ah = __builtin_bit_cast(bf16x8, hw), al = __builtin_bit_cast(bf16x8, lw);
                    const bf16x8 bh0 = *(const bf16x8*)(wh + 32 * s), bh1 = *(const bf16x8*)(wh + 16 * 2048 + 32 * s), bl0 = *(const bf16x8*)(wl + 32 * s), bl1 = *(const bf16x8*)(wl + 16 * 2048 + 32 * s);
                    acc0 = MFMA16(bh0, ah, acc0); acc0 = MFMA16(bh0, al, acc0); acc0 = MFMA16(bl0, ah, acc0);
                    acc1 = MFMA16(bh1, ah, acc1); acc1 = MFMA16(bh1, al, acc1); acc1 = MFMA16(bl1, ah, acc1); }
                LAS float* lgw = lgp + ((tsk * 4 + kq) * 16 + fr) * 32;
                *(LAS f32x4*)(lgw + 4 * fq) = acc0; *(LAS f32x4*)(lgw + 16 + 4 * fq) = acc1;
                __syncthreads();
                if (kq == 0 && !KA(rep)) { LAS float* lg = lgp + (tsk * 4) * 16 * 32; const float* br = KA(b_router) + l * 32;
                    float v[8]; const int e0 = 8 * fq;
#pragma unroll
                    for (int e = 0; e < 8; ++e) { const int idx = fr * 32 + e0 + e; v[e] = ((lg[idx] + lg[512 + idx]) + (lg[1024 + idx] + lg[1536 + idx])) + br[e0 + e]; }
                    float tv[4]; int te[4];
#pragma unroll
                    for (int k = 0; k < 4; ++k) { float best = v[0]; int be = 0;
#pragma unroll
                        for (int e = 1; e < 8; ++e) if (v[e] > best) { best = v[e]; be = e; }
                        be += e0;
#pragma unroll
                        for (int o = 16; o < 64; o <<= 1) { const float ob = __shfl_xor(best, o); const int oe = __shfl_xor(be, o); if (ob > best || (ob == best && oe < be)) { best = ob; be = oe; } }
                        tv[k] = best; te[k] = be;
#pragma unroll
                        for (int e = 0; e < 8; ++e) if (be == e0 + e) v[e] = -3.0e38f; }
                    const float e1 = __expf(tv[1] - tv[0]), e2 = __expf(tv[2] - tv[0]), e3 = __expf(tv[3] - tv[0]); const float inv = 1.f / (1.f + e1 + e2 + e3);
                    const int rr = rbeg + (pair * 2 + tsk) * 16 + fr;
                    const int me = fq == 0 ? te[0] : (fq == 1 ? te[1] : (fq == 2 ? te[2] : te[3])); const float mg = fq == 0 ? inv : (fq == 1 ? e1 * inv : (fq == 2 ? e2 * inv : e3 * inv));
                    const unsigned rank = atomicAdd(CNT + me * 64, 1u); LIST[(size_t)me * ROWS + rank] = rr; TOKI[rr * 4 + fq] = (me << 16) | (int)rank; GATE[rr * 4 + fq] = mg;
                }
                __syncthreads();
            }
        }
        SEAM(pb + 6);
        if (IN(pb + 7) || IN(pb + 8) || IN(pb + 9)) {
            LAS int* tb = (LAS int*)(lds + LDSCTL_OFF + LC_TB); LAS int* cn = (LAS int*)(lds + LDSCTL_OFF + LC_CNT); const int tid = opaque_tid();
            __syncthreads();
            if (tid < 32) cn[tid] = (int)__hip_atomic_load(CNT + tid * 64, __ATOMIC_RELAXED, __HIP_MEMORY_SCOPE_AGENT);
            __syncthreads();
            if (tid == 0) { int s = 0; for (int e = 0; e < 32; ++e) { tb[e] = s; s += (cn[e] + 255) >> 8; } tb[32] = s; }
            __syncthreads();
        }
        if (PHEN(10) && IN(pb + 7)) { PHASE_IDS
            pg8::MoeSched S; S.tb = (const LAS int*)(lds + LDSCTL_OFF + LC_TB); S.cnt = (const LAS int*)(lds + LDSCTL_OFF + LC_CNT); S.A = (const char*)FB; S.B = (const char*)WGU + (size_t)l * 32 * 2048 * 2048;
            S.sB = (size_t)2048 * 2048; S.list = LIST; S.lda = D / 2; S.ldb = 1024; S.nN = 8; S.G = G; S.c = bx; S.gather = true;
            EpiGateUp E{(unsigned char*)HB, KA(b_gate_up) + (size_t)l * 32 * 2048};
            pg8::gemm_phase<EpiGateUp, pg8::MoeSched, true, true>(lds, D / 2, 1024, 1024, S, E);
        }
        SEAM(pb + 7);
        if (PHEN(11) && IN(pb + 8)) { PHASE_IDS
            pg8::MoeSched S; S.tb = (const LAS int*)(lds + LDSCTL_OFF + LC_TB); S.cnt = (const LAS int*)(lds + LDSCTL_OFF + LC_CNT); S.A = (const char*)HB; S.B = (const char*)WDN + (size_t)l * 32 * 2048 * 1024;
            S.sB = (size_t)2048 * 1024; S.list = LIST; S.lda = DE / 2; S.ldb = DE / 2; S.nN = 8; S.G = G; S.c = bx; S.gather = false;
            EpiDown E{YB, KA(b_down) + (size_t)l * 32 * 2048};
            pg8::gemm_phase<EpiDown, pg8::MoeSched, false, true>(lds, DE / 2, DE / 2, DE / 2, S, E);
        }
        SEAM(pb + 8);
        if (PHEN(12) && IN(pb + 9)) { PHASE_IDS
            const LAS int* tb = (const LAS int*)(lds + LDSCTL_OFF + LC_TB);
            const int rbeg = (l == NL - 1) ? CTXL : 0;
            for (int r0 = rbeg + gw; r0 < ROWS; r0 += 2 * NGW) {
                int rr[2]; rr[0] = r0; rr[1] = (r0 + NGW < ROWS) ? r0 + NGW : r0; const bool two = (r0 + NGW < ROWS);
                const bf16_t* yp[2][4]; float gk[2][4];
#pragma unroll
                for (int a_ = 0; a_ < 2; ++a_)
#pragma unroll
                    for (int k = 0; k < 4; ++k) { const int ti = TOKI[rr[a_] * 4 + k]; const int e = ti >> 16, rank = ti & 0xffff; yp[a_][k] = YB + ((size_t)tb[e] * 256 + rank) * D; gk[a_][k] = GATE[rr[a_] * 4 + k]; }
                f32x4 xo[2][4][2]; float ss[2] = {0.f, 0.f};
#pragma unroll
                for (int a_ = 0; a_ < 2; ++a_) { const bf16_t* x1 = XA + (size_t)rr[a_] * D; const float* g2 = MODL + (rr[a_] < CTXL ? 12288 : 0) + 5 * 2048;
#pragma unroll
                    for (int i = 0; i < 4; ++i) { const int c = lane * 8 + 512 * i; f32x4 s0 = {0.f, 0.f, 0.f, 0.f}, s1 = {0.f, 0.f, 0.f, 0.f};
#pragma unroll
                        for (int k = 0; k < 4; ++k) { const bf16x8 y = *(const bf16x8*)(yp[a_][k] + c);
                            s0 += (f32x4){bfs2f(y[0]), bfs2f(y[1]), bfs2f(y[2]), bfs2f(y[3])} * gk[a_][k]; s1 += (f32x4){bfs2f(y[4]), bfs2f(y[5]), bfs2f(y[6]), bfs2f(y[7])} * gk[a_][k]; }
                        { f32x4 xa0, xa1; ld8_bf16(x1 + c, xa0, xa1); xo[a_][i][0] = xa0 + *(const f32x4*)(g2 + c) * s0; xo[a_][i][1] = xa1 + *(const f32x4*)(g2 + c + 4) * s1; }
#pragma unroll
                        for (int q = 0; q < 4; ++q) ss[a_] += xo[a_][i][0][q] * xo[a_][i][0][q] + xo[a_][i][1][q] * xo[a_][i][1][q]; } }
#pragma unroll
                for (int a_ = 0; a_ < 2; ++a_) { if (a_ == 1 && !two) break; const int r = rr[a_];
                    if (l == NL - 1) {
#pragma unroll
                        for (int i = 0; i < 4; ++i) { const int c = lane * 8 + 512 * i; float* o = KA(out) + (size_t)(r - CTXL) * D + c; *(f32x4*)o = xo[a_][i][0]; *(f32x4*)(o + 4) = xo[a_][i][1]; }
                    } else {
                        const float rstd = __builtin_amdgcn_rsqf(wave_sum(ss[a_]) * (1.f / D) + EPS); const float* md = MOD + (size_t)(l + 1) * 2 * 12288 + (r < CTXL ? 12288 : 0);
                        f32x4 msc[4][2], msh[4][2];
#pragma unroll
                        for (int i = 0; i < 4; ++i) { const int c = lane * 8 + 512 * i; msc[i][0] = *(const f32x4*)(md + 2048 + c); msc[i][1] = *(const f32x4*)(md + 2048 + c + 4); msh[i][0] = *(const f32x4*)(md + c); msh[i][1] = *(const f32x4*)(md + c + 4); }
#pragma unroll
                        for (int i = 0; i < 4; ++i) { const int c = lane * 8 + 512 * i; st8_bf16(XB + (size_t)r * D + c, xo[a_][i][0], xo[a_][i][1]);
                            const f32x4 n0 = xo[a_][i][0] * rstd * (msc[i][0] + 1.f) + msh[i][0], n1 = xo[a_][i][1] * rstd * (msc[i][1] + 1.f) + msh[i][1];
                            u32x4 w; w.x = cvt_pk_bf16(n0[0], n0[1]); w.y = cvt_pk_bf16(n0[2], n0[3]); w.z = cvt_pk_bf16(n1[0], n1[1]); w.w = cvt_pk_bf16(n1[2], n1[3]); *(u32x4*)(XN + (size_t)r * D + c) = w; }
                    } }
            }
        }
        SEAM(pb + 9);
    }
#undef IN
#undef SEAM
}

extern "C" void kernel_launch(void* const* d_in, const int* in_sizes, int n_in, void* d_out, int out_size, void* d_ws, size_t ws_size, hipStream_t stream) {
    static int grid = 0;
    if (grid == 0) {
        if (n_in != 27 || out_size != SEQ * D || ws_size < WS_END) { fprintf(stderr, "kernel_launch: unexpected shapes: n_in %d out %d ws %zu (need %zu)\n", n_in, out_size, ws_size, (size_t)WS_END); grid = -1; return; }
        int dev = 0, cus = 0, per_cu = 0;
        if (hipGetDevice(&dev) != hipSuccess || hipDeviceGetAttribute(&cus, hipDeviceAttributeMultiprocessorCount, dev) != hipSuccess) { grid = -1; return; }
        if (hipFuncSetAttribute((const void*)mega_fwd, hipFuncAttributeMaxDynamicSharedMemorySize, LDS_BYTES) != hipSuccess) { fprintf(stderr, "kernel_launch: hipFuncSetAttribute failed\n"); grid = -1; return; }
        if (hipOccupancyMaxActiveBlocksPerMultiprocessor(&per_cu, (const void*)mega_fwd, 512, LDS_BYTES) != hipSuccess || per_cu < 1) { fprintf(stderr, "kernel_launch: occupancy query reports %d blocks per CU\n", per_cu); }
        (void)hipGetLastError();
        grid = cus;
    }
    if (grid < 0) return;
    if (hipMemsetAsync((char*)d_ws + WS_CTL, 0, CTL_BYTES, stream) != hipSuccess) { fprintf(stderr, "kernel_launch: memset failed\n"); return; }
    Args a{};
    const float** fp = (const float**)&a.x;
    for (int i = 0; i < 27; ++i) fp[i] = (const float*)d_in[i];
    a.out = (float*)d_out; a.ws = (unsigned char*)d_ws;
#if MK_MULTI
#ifndef REPMASK
#define REPMASK 0
#endif
    for (int p = 0; p < NPH; ++p) { a.ph_lo = p; a.ph_hi = p + 1; a.rep = 0; hipLaunchKernelGGL(mega_fwd, dim3(grid), dim3(512), LDS_BYTES, stream, a);
        const int ty = p < 3 ? p : 3 + (p - 3) % 10;
        if ((REPMASK >> ty) & 1) { a.rep = 1; hipLaunchKernelGGL(mega_fwd, dim3(grid), dim3(512), LDS_BYTES, stream, a); } }
#else
    a.ph_lo = 0; a.ph_hi = NPH; hipLaunchKernelGGL(mega_fwd, dim3(grid), dim3(512), LDS_BYTES, stream, a);
#endif
    const hipError_t le = hipPeekAtLastError();
    if (le != hipSuccess) fprintf(stderr, "kernel_launch: launch failed: %s\n", hipGetErrorName(le));
}
```

```cpp
#include <hip/hip_runtime.h>
#include <cstdio>
#include <cstdint>

#ifndef MK_MULTI
#define MK_MULTI 0
#endif

#define LAS __attribute__((address_space(3)))
typedef unsigned short bf16_t;
typedef short bf16x8 __attribute__((ext_vector_type(8)));
typedef short s16x4 __attribute__((ext_vector_type(4)));
typedef float f32x4 __attribute__((ext_vector_type(4)));
typedef float f32x2 __attribute__((ext_vector_type(2)));
typedef float f32x16 __attribute__((ext_vector_type(16)));
typedef unsigned u32x4 __attribute__((ext_vector_type(4)));
typedef unsigned u32x2 __attribute__((ext_vector_type(2)));

constexpr int D = 2048, SEQ = 8192, CTXL = 256, ROWS = SEQ + CTXL, INC = 5632, NL = 2;
constexpr int ZC_RQ = 0, ZC_RK = 512, ZC_RV = 1024, ZC_GF = 1536, ZC_GB = 2048, ZC_U = 2560, ZC_AQ = 3072, ZC_AK = 3584, ZC_AV = 3840, ZC_CB = 4096, ZC_CC = 4608, ZC_CH = 5120;
constexpr int NE = 32, DE = 1024;
constexpr int NBLK = ROWS / 128;
constexpr int NCH = ROWS / 32;
constexpr int HROWS = 42240;
constexpr float EPS = 1e-6f;
constexpr float LOG2_1E4 = 13.287712379549449f;
constexpr int NPH = 3 + 10 * NL;

constexpr size_t al256(size_t x) { return (x + 255) / 256 * 256; }
constexpr size_t WS_CTL = 0, CTL_BYTES = 65536;
constexpr int CW_BAR = 0, CW_CNT = 10240, CW_Q8 = 9344, CW_QB = 9408, CW_PG = 9472;
constexpr size_t WS_MODP = al256(WS_CTL + CTL_BYTES);
constexpr size_t WS_MOD = al256(WS_MODP + (size_t)32 * 2 * 2 * 12288 * 4);
constexpr size_t WS_WIN = al256(WS_MOD + (size_t)2 * 2 * 12288 * 4);
constexpr size_t WS_WOUT = al256(WS_WIN + (size_t)2 * INC * D * 2);
constexpr size_t WS_WGLU = al256(WS_WOUT + (size_t)2 * D * D * 2);
constexpr size_t WS_WGU = al256(WS_WGLU + (size_t)2 * 512 * 512 * 2);
constexpr size_t WS_WDN = al256(WS_WGU + (size_t)2 * NE * 2048 * 2048 * 2);
constexpr size_t WS_WRT = al256(WS_WDN + (size_t)2 * NE * 2048 * 1024 * 2);
constexpr size_t WS_KTAB = al256(WS_WRT + (size_t)2 * 2 * 32 * 2048 * 2);
constexpr size_t WS_WE = al256(WS_KTAB + (size_t)2 * 32 * 2 * 32 * 256 * 4);
constexpr size_t WS_WTC = al256(WS_WE + (size_t)2 * 32 * 256 * 512 * 2);
constexpr size_t WS_APOW = al256(WS_WTC + (size_t)2 * 32 * 512 * 768 * 2);
constexpr size_t WS_XN = al256(WS_APOW + (size_t)2 * 32 * 2 * 64 * 2 * 4);
constexpr size_t WS_Z = al256(WS_XN + (size_t)ROWS * D * 2);
constexpr size_t WS_UPX = al256(WS_Z + (size_t)ROWS * INC * 2);
constexpr size_t WS_E = al256(WS_UPX + (size_t)32 * 512 * 768 * 2);
constexpr size_t WS_KVT = al256(WS_E + (size_t)32 * 512 * 256 * 4);
constexpr size_t WS_SPREV = al256(WS_KVT + (size_t)NBLK * 8 * 16384 * 4);
constexpr size_t WS_OP = al256(WS_SPREV + (size_t)NBLK * 8 * 16384 * 2);
constexpr size_t WS_ML = al256(WS_OP + (size_t)2 * ROWS * 512 * 4);
constexpr size_t WS_YG = al256(WS_ML + (size_t)2 * ROWS * 8 * 4);
constexpr size_t WS_MIX = al256(WS_YG + (size_t)ROWS * 512 * 2);
constexpr size_t WS_XA = al256(WS_MIX + (size_t)ROWS * D * 2);
constexpr size_t WS_XB = al256(WS_XA + (size_t)ROWS * D * 4);
constexpr size_t WS_F = al256(WS_XB + (size_t)ROWS * D * 4);
constexpr size_t WS_LIST = al256(WS_F + (size_t)ROWS * D * 2);
constexpr size_t WS_TOKI = al256(WS_LIST + (size_t)NE * ROWS * 4);
constexpr size_t WS_GATE = al256(WS_TOKI + (size_t)ROWS * 4 * 4);
constexpr size_t WS_H = al256(WS_GATE + (size_t)ROWS * 4 * 4);
constexpr size_t WS_Y = al256(WS_H + (size_t)HROWS * DE * 2);
constexpr size_t WS_END = al256(WS_Y + (size_t)HROWS * D * 2);

constexpr int RING_BYTES = 131072, LDSCTL_OFF = 155648, LDS_BYTES = 159744;
constexpr int LC_BAR = 0, LC_TB = 64, LC_CNT = 256, LC_TE = 384, LC_RM = 2048;

constexpr int PGA_IPB = 352, PGA_J0 = 32, PGA_NI = 44;
constexpr int PGA_LAND = 69632, PGA_TILE = 135168;
__device__ __forceinline__ unsigned f2bf(float f) { unsigned u = __builtin_bit_cast(unsigned, f); return (u + 0x7fffu + ((u >> 16) & 1u)) >> 16; }
__device__ __forceinline__ float bf2f(unsigned h) { return __builtin_bit_cast(float, (h & 0xffffu) << 16); }
__device__ __forceinline__ float bfs2f(short h) { return __builtin_bit_cast(float, ((unsigned)(unsigned short)h) << 16); }
__device__ __forceinline__ unsigned cvt_pk_bf16(float lo, float hi) { unsigned r; asm volatile("v_cvt_pk_bf16_f32 %0, %1, %2" : "=v"(r) : "v"(lo), "v"(hi)); return r; }
__device__ __forceinline__ float wave_sum(float v) {
#pragma unroll
    for (int o = 1; o < 64; o <<= 1) v += __shfl_xor(v, o);
    return v;
}
__device__ __forceinline__ float sigmoid_(float x) { return __builtin_amdgcn_rcpf(1.f + __builtin_amdgcn_exp2f(-1.4426950408889634f * x)); }
__device__ __forceinline__ float silu_(float x) { return x * sigmoid_(x); }
__device__ __forceinline__ float gelu_tanh_(float x) { const float u = 0.7978845608028654f * (x + 0.044715f * x * x * x); return x * __builtin_amdgcn_rcpf(1.f + __builtin_amdgcn_exp2f(-2.8853900817779268f * u)); }
__device__ __forceinline__ void sincos_ang(float ang, float& s, float& c) { float t = ang * 0.15915494309189535f; t = t - floorf(t); s = __builtin_amdgcn_sinf(t); c = __builtin_amdgcn_cosf(t); }
__device__ __forceinline__ int opaque_tid() { int t = threadIdx.x; asm volatile("" : "+v"(t)); return t; }
__device__ __forceinline__ unsigned pk4_fp8(float a, float b, float c, float d) { int r = __builtin_amdgcn_cvt_pk_fp8_f32(a, b, 0, false); r = __builtin_amdgcn_cvt_pk_fp8_f32(c, d, r, true); return (unsigned)r; }
constexpr float W8_SCALE = 64.f, W8_INV = 1.f / 64.f;
__device__ __forceinline__ int lane_now() { int l; asm volatile("v_mbcnt_lo_u32_b32 %0, -1, 0\n\tv_mbcnt_hi_u32_b32 %0, -1, %0" : "=v"(l)); return l; }
struct PgA { const float* wgu; const float* wdn; unsigned char* WGU8; unsigned char* WDN8; int it0; int c0; };
__device__ __forceinline__ void pga_decode(const PgA& P, int j, const float*& src, unsigned char*& dst, int& ldk) {
    const int idx = (j + PGA_J0) * 256 + P.it0;
    if (idx < 32768 || (idx >= 49152 && idx < 81920)) { const int gi = idx < 32768 ? idx : idx - 16384, e = gi >> 10, q = gi & 1023, kt = q >> 5, nt = q & 31; ldk = 2048;
        src = P.wgu + (size_t)e * 2048 * 2048 + (size_t)kt * 64 * 2048 + nt * 64; dst = P.WGU8 + (size_t)e * 2048 * 2048 + (size_t)nt * 64 * 2048 + kt * 64; }
    else { const int di = idx < 49152 ? idx - 32768 : idx - 81920 + 16384, e = di >> 9, q = di & 511, kt = q >> 5, nt = q & 31; ldk = 1024;
        src = P.wdn + (size_t)e * 1024 * 2048 + (size_t)kt * 64 * 2048 + nt * 64; dst = P.WDN8 + (size_t)e * 2048 * 1024 + (size_t)nt * 64 * 1024 + kt * 64; }
}
__device__ __forceinline__ void pga_rb(const PgA& P, LAS unsigned char* lds, int s, int nissue, int wid) {
    const int hf = wid >> 2, u = (wid & 3) * 64 + lane_now(), n = u >> 2, c = u & 3;
#pragma unroll
    for (int t = 0; t < 2; ++t) { const int ia = P.c0 + 4 * (s - 2) + 2 * hf + t;
      if (s >= 2 && s - 2 < nissue && ia < PGA_IPB) { const float* src; unsigned char* dst; int ldk; pga_decode(P, ia, src, dst, ldk); (void)src;
        LAS unsigned char* T = lds + PGA_TILE + (hf * 2 + t) * 4096; u32x4 w;
        w.x = *(const LAS unsigned*)(T + (n * 16 + ((4 * c + 0 + (n >> 2)) & 15)) * 4); w.y = *(const LAS unsigned*)(T + (n * 16 + ((4 * c + 1 + (n >> 2)) & 15)) * 4);
        w.z = *(const LAS unsigned*)(T + (n * 16 + ((4 * c + 2 + (n >> 2)) & 15)) * 4); w.w = *(const LAS unsigned*)(T + (n * 16 + ((4 * c + 3 + (n >> 2)) & 15)) * 4);
        *(u32x4*)(dst + (size_t)n * ldk + c * 16) = w; } }
}
__device__ __forceinline__ void pga_ci(const PgA& P, LAS unsigned char* lds, int s, int nissue, int wid) {
    const int hf = wid >> 2, ln = lane_now(), u = (wid & 3) * 64 + ln, kq = u >> 4, n4 = u & 15;
#pragma unroll
    for (int t = 0; t < 2; ++t) { const int ib = P.c0 + 4 * (s - 1) + 2 * hf + t;
      if (s >= 1 && s - 1 < nissue && ib < PGA_IPB) { LAS unsigned char* T = lds + PGA_TILE + (hf * 2 + t) * 4096; const LAS unsigned char* L = lds + PGA_LAND + t * 32768 + wid * 1024 + ln * 16;
#pragma unroll
        for (int e = 0; e < 4; ++e) { const float v0 = *(const LAS float*)(L + e * 4), v1 = *(const LAS float*)(L + 8192 + e * 4), v2 = *(const LAS float*)(L + 16384 + e * 4), v3 = *(const LAS float*)(L + 24576 + e * 4);
            *(LAS unsigned*)(T + ((4 * n4 + e) * 16 + ((kq + n4) & 15)) * 4) = pk4_fp8(v0 * W8_SCALE, v1 * W8_SCALE, v2 * W8_SCALE, v3 * W8_SCALE); } } }
    if (s < nissue) asm volatile("s_waitcnt lgkmcnt(0)" ::: "memory");
#pragma unroll
    for (int t = 0; t < 2; ++t) { const int ic = P.c0 + 4 * s + 2 * hf + t;
      if (s < nissue && ic < PGA_IPB) { const float* src; unsigned char* dst; int ldk; pga_decode(P, ic, src, dst, ldk); (void)dst; (void)ldk;
        const float* p = src + (size_t)(4 * kq) * 2048 + n4 * 4;
#pragma unroll
        for (int r = 0; r < 4; ++r) __builtin_amdgcn_global_load_lds((const unsigned*)(p + (size_t)r * 2048), (LAS unsigned*)(lds + PGA_LAND + t * 32768 + r * 8192 + wid * 1024), 16, 0, 0); } }
}
#define MFMA16(a, b, c) __builtin_amdgcn_mfma_f32_16x16x32_bf16((a), (b), (c), 0, 0, 0)

#define XB_TMO      128
#define XB_XCNT(j)  (256  + 64 * (j))
#define XB_XSUB(j)  (1280 + 64 * (j))
#define XB_XGEN(j)  (2304 + 64 * (j))
#define XB_TOP      3328
#define XB_TOPGEN   3392
#define XCD_BAR_WORDS 3456
#define XB_SPIN_CAP (1u << 18)
__device__ __forceinline__ unsigned xb_ld(unsigned* p)              { return __hip_atomic_load(p, __ATOMIC_RELAXED, __HIP_MEMORY_SCOPE_AGENT); }
__device__ __forceinline__ unsigned xb_add(unsigned* p, unsigned v) { return __hip_atomic_fetch_add(p, v, __ATOMIC_RELAXED, __HIP_MEMORY_SCOPE_AGENT); }
__device__ __forceinline__ unsigned xb_xcc_id() { return (unsigned)__builtin_amdgcn_s_getreg((3 << 11) | 20) & 0xFu; }
#define XB_SPIN(cond, bar) do { unsigned _sp = 0; while (cond) { __builtin_amdgcn_s_sleep(1); \
    if ((++_sp & 255u) == 0u) { if (xb_ld(&(bar)[XB_TMO])) break; if (_sp > XB_SPIN_CAP) { atomicAdd(&(bar)[XB_TMO], 1u); break; } } } } while (0)
struct XcdBarrier { unsigned* bar; unsigned x; volatile LAS unsigned* st; };
__device__ __forceinline__ XcdBarrier xcd_barrier_post(unsigned* bar, volatile LAS unsigned* st) {
    XcdBarrier b; b.bar = bar; b.x = xb_xcc_id(); b.st = st;
    if (threadIdx.x == 0) (void)xb_add(&bar[XB_XCNT(b.x)], 1u);
    return b;
}
__device__ __forceinline__ void xcd_barrier_complete(unsigned* bar, unsigned x, unsigned& nloc, unsigned& nx) {
    const unsigned G = gridDim.x * gridDim.y * gridDim.z;
    unsigned sum, cnt, mine, sp = 0u;
    for (;;) {
        sum = 0u; cnt = 0u; mine = 0u;
#pragma unroll
        for (unsigned j = 0; j < 16; ++j) { const unsigned c = xb_ld(&bar[XB_XCNT(j)]); sum += c; cnt += (c > 0u) ? 1u : 0u; mine = (j == x) ? c : mine; }
        if (sum == G) break;
        __builtin_amdgcn_s_sleep(1);
        if ((++sp & 255u) == 0u) { if (xb_ld(&bar[XB_TMO])) break; if (sp > XB_SPIN_CAP) { atomicAdd(&bar[XB_TMO], 1u); break; } }
    }
    nloc = mine > 0u ? mine : 1u; nx = cnt > 0u ? cnt : 1u;
}
__device__ __forceinline__ void xcd_barrier(const XcdBarrier& b) {
    asm volatile("s_waitcnt vmcnt(0)" ::: "memory");
    __syncthreads();
    if (threadIdx.x == 0) {
        unsigned* bar = b.bar;
        __builtin_amdgcn_s_waitcnt(0);
        unsigned nloc = b.st[0], nx = b.st[1];
        if (nloc == 0u) { xcd_barrier_complete(bar, b.x, nloc, nx); b.st[0] = nloc; b.st[1] = nx; }
        const unsigned old = xb_add(&bar[XB_XSUB(b.x)], 1u);
        const unsigned gen = old / nloc;
        if (old + 1u == (gen + 1u) * nloc) {
            __builtin_amdgcn_fence(__ATOMIC_RELEASE, "agent");
            asm volatile("s_waitcnt vmcnt(0)" ::: "memory");
            const unsigned og = xb_add(&bar[XB_TOP], 1u);
            const unsigned tg = og / nx;
            if (og + 1u == (tg + 1u) * nx) xb_add(&bar[XB_TOPGEN], 1u);
            else XB_SPIN(xb_ld(&bar[XB_TOPGEN]) == tg, bar);
            __builtin_amdgcn_fence(__ATOMIC_ACQUIRE, "agent");
            xb_add(&bar[XB_XGEN(b.x)], 1u);
            asm volatile("s_waitcnt vmcnt(0)" ::: "memory");
        } else {
            XB_SPIN(xb_ld(&bar[XB_XGEN(b.x)]) == gen, bar);
            __builtin_amdgcn_fence(__ATOMIC_ACQUIRE, "agent");
            asm volatile("s_waitcnt vmcnt(0)" ::: "memory");
        }
    }
    __syncthreads();
}

namespace pg8 {
constexpr int BM = 256, BK = 64, HALF = 128, HTB = HALF * BK * 2, STAGE_BYTES = 8 * HTB, NXCD = 8, WGM = 8;
__device__ __forceinline__ int lds_byte(int r, int c) { const int st = (r >> 4) * 2 + (c >> 5), rr = r & 15, cc = c & 31, ob = rr * 64 + cc * 2; return st * 1024 + (ob ^ (((ob >> 9) & 1) << 5)); }
__device__ __forceinline__ void stage_rc(int b, int& R, int& C) { const int st = b / 1024, sb = b % 1024, swz = sb ^ (((sb >> 9) & 1) << 5); R = (st >> 1) * 16 + swz / 64; C = (st & 1) * 32 + (swz % 64) / 2; }
__device__ __forceinline__ int perm32(int rho) { const int n = rho >> 4, i = rho & 15; return 8 * (i >> 2) + 4 * n + (i & 3); }

struct Unit { const char* A; const char* B; const int* rowmap; int nvalid; int pm, pn, aux; };

template <class Epi, class Sched, bool GATHER, bool FP8 = false>
__device__ __forceinline__ void gemm_phase(LAS unsigned char* lds, const int lda, const int ldb, const int K, const Sched& S, const Epi& E) {
    const int tid = opaque_tid(), wid = __builtin_amdgcn_readfirstlane(tid >> 6), lane = tid & 63, wr = wid >> 2, wc = wid & 3, fr = lane & 15, fq = lane >> 4;
    const int nt = K / BK;
    unsigned voffA[2][2], nvoffA[2][2], voffB[2];
#pragma unroll
    for (int i = 0; i < 2; ++i) { int R, C; stage_rc(tid * 16 + i * 8192, R, C); const int Rb = (R & ~31) + perm32(R & 31);
        voffA[0][i] = (unsigned)(R * lda + C) * 2u; voffA[1][i] = voffA[0][i]; nvoffA[0][i] = voffA[0][i]; nvoffA[1][i] = voffA[0][i]; voffB[i] = (unsigned)(Rb * ldb + C) * 2u; }
    const size_t kstep = (size_t)(BK * 2);
    const size_t hstepA = GATHER ? 0 : (size_t)HALF * lda * 2, hstepB = (size_t)HALF * ldb * 2;
    const unsigned ldsw = (unsigned)wid * 1024u;
    const int aoff = lds_byte(wr * 64 + fr, fq * 8), boff = lds_byte(wc * 32 + fr, fq * 8);
#define PG8_SA(b, h) (((b) * 2 + (h)) * HTB)
#define PG8_SB(b, h) ((4 + (b) * 2 + (h)) * HTB)
#define PG8_STAGE_B(bufoff, gbase) do { _Pragma("unroll") for (int _i = 0; _i < 2; ++_i) \
        __builtin_amdgcn_global_load_lds((const unsigned*)((const char*)(gbase) + voffB[_i]), (LAS unsigned*)(lds + (bufoff) + ldsw + _i * 8192), 16, 0, 0); } while (0)
#define PG8_STAGE_A(bufoff, gbase, h, usenext) do { _Pragma("unroll") for (int _i = 0; _i < 2; ++_i) { \
        const unsigned _o = (GATHER && (usenext)) ? nvoffA[h][_i] : voffA[h][_i]; \
        __builtin_amdgcn_global_load_lds((const unsigned*)((const char*)(gbase) + (h) * hstepA + _o), (LAS unsigned*)(lds + (bufoff) + ldsw + _i * 8192), 16, 0, 0); } } while (0)
#define PG8_LDA(dst, b, h) do { _Pragma("unroll") for (int m = 0; m < 4; ++m) _Pragma("unroll") for (int k = 0; k < 2; ++k) dst[m][k] = *(const LAS bf16x8*)(lds + PG8_SA(b, h) + aoff + m * 2048 + k * 1024); } while (0)
#define PG8_LDB(dst, b, h) do { _Pragma("unroll") for (int n = 0; n < 2; ++n) _Pragma("unroll") for (int k = 0; k < 2; ++k) dst[n][k] = *(const LAS bf16x8*)(lds + PG8_SB(b, h) + boff + n * 2048 + k * 1024); } while (0)
#define PG8_MMA(ai, bj, At, Bt) do { __builtin_amdgcn_s_setprio(1); _Pragma("unroll") for (int m = 0; m < 4; ++m) _Pragma("unroll") for (int n = 0; n < 2; ++n) { \
        if constexpr (FP8) { typedef int v8i_t __attribute__((ext_vector_type(8))); typedef int v4i_t __attribute__((ext_vector_type(4))); \
            const v4i_t _b0 = __builtin_bit_cast(v4i_t, Bt[n][0]), _b1 = __builtin_bit_cast(v4i_t, Bt[n][1]), _a0 = __builtin_bit_cast(v4i_t, At[m][0]), _a1 = __builtin_bit_cast(v4i_t, At[m][1]); \
            const v8i_t _b = {_b0[0], _b0[1], _b0[2], _b0[3], _b1[0], _b1[1], _b1[2], _b1[3]}, _a = {_a0[0], _a0[1], _a0[2], _a0[3], _a1[0], _a1[1], _a1[2], _a1[3]}; \
              \
            asm volatile("v_mfma_scale_f32_16x16x128_f8f6f4 %0, %1, %2, %0, %3, %3 op_sel_hi:[0,0,0]" : "+v"(acc[ai][bj][m][n]) : "v"(_b), "v"(_a), "v"(pg8_scale1)); } \
        else { _Pragma("unroll") for (int k = 0; k < 2; ++k) acc[ai][bj][m][n] = __builtin_amdgcn_mfma_f32_16x16x32_bf16(Bt[n][k], At[m][k], acc[ai][bj][m][n], 0, 0, 0); } } __builtin_amdgcn_s_setprio(0); } while (0)
#define PG8_WAIT_V(n) asm volatile("s_waitcnt vmcnt(" #n ")" ::: "memory")
#define PG8_WAIT_L(n) asm volatile("s_waitcnt lgkmcnt(" #n ")" ::: "memory")
#define PG8_WAIT_VP(post) do { if (post) asm volatile("s_waitcnt vmcnt(%0)" :: "n"(8 + Epi::NST) : "memory"); else PG8_WAIT_V(8); } while (0)
#define PG8_BAR __builtin_amdgcn_s_barrier()
#define PG8_SCHED __builtin_amdgcn_sched_barrier(0)
#define PG8_GOFF(dst, u) do { if constexpr (GATHER) { const int _t = opaque_tid(); int _v[2][2]; _Pragma("unroll") for (int _i = 0; _i < 2; ++_i) { int _R, _C; stage_rc(_t * 16 + _i * 8192, _R, _C); \
        _Pragma("unroll") for (int _h = 0; _h < 2; ++_h) { const int _r = _h * HALF + _R; _v[_h][_i] = (u).rowmap[_r < (u).nvalid ? _r : 0]; } } \
        _Pragma("unroll") for (int _i = 0; _i < 2; ++_i) { int _R, _C; stage_rc(_t * 16 + _i * 8192, _R, _C); _Pragma("unroll") for (int _h = 0; _h < 2; ++_h) dst[_h][_i] = (unsigned)(_v[_h][_i] * lda + _C) * 2u; } } } while (0)
#define PG8_RM_ISSUE(u) __builtin_amdgcn_global_load_lds((const unsigned*)((u).rowmap + (opaque_tid() & 255)), (LAS unsigned*)(lds + LDSCTL_OFF + LC_RM + (wid & 3) * 256), 4, 0, 0)
#define PG8_RM_READ(dst, u) do { const int _t = opaque_tid(); _Pragma("unroll") for (int _i = 0; _i < 2; ++_i) { int _R, _C; stage_rc(_t * 16 + _i * 8192, _R, _C); \
        _Pragma("unroll") for (int _h = 0; _h < 2; ++_h) { const int _r = _h * HALF + _R; const int _e = *(const LAS int*)(lds + LDSCTL_OFF + LC_RM + _r * 4); const int _src = (_r < (u).nvalid) ? _e : 0; dst[_h][_i] = (unsigned)(_src * lda + _C) * 2u; } } } while (0)
    Unit cur, nxt; int ui = 0;
    if (!S.next(0, cur)) return;
    f32x4 acc[2][2][4][2];
    const int pg8_scale1 = 0x7f7f7f7f;
#pragma unroll
    for (int a = 0; a < 2; ++a)
#pragma unroll
        for (int b = 0; b < 2; ++b)
#pragma unroll
            for (int m = 0; m < 4; ++m)
#pragma unroll
                for (int n = 0; n < 2; ++n) { acc[a][b][m][n] = (f32x4){0.f, 0.f, 0.f, 0.f}; }
    bf16x8 At[4][2], B0[2][2], B1[2][2];
    const char* cA = cur.A; const char* cB = cur.B;
    PG8_GOFF(voffA, cur);
    PG8_STAGE_B(PG8_SB(0, 0), cB); PG8_STAGE_B(PG8_SB(0, 1), cB + hstepB); PG8_STAGE_A(PG8_SA(0, 0), cA, 0, false); PG8_STAGE_A(PG8_SA(0, 1), cA, 1, false);
    if (wr == 1) PG8_BAR;
    PG8_WAIT_V(2); PG8_BAR;
    PG8_STAGE_B(PG8_SB(1, 0), cB + kstep); PG8_STAGE_A(PG8_SA(1, 0), cA + kstep, 0, false); PG8_STAGE_B(PG8_SB(1, 1), cB + hstepB + kstep);
    PG8_WAIT_V(6); PG8_BAR;
    for (;;) {
        const bool has_next = S.next(ui + 1, nxt);
        const char* nA = has_next ? nxt.A : cA; const char* nB = has_next ? nxt.B : cB;
        if constexpr (GATHER) { if (has_next) { PG8_RM_ISSUE(nxt); } else {
#pragma unroll
            for (int _h = 0; _h < 2; ++_h)
#pragma unroll
                for (int _i = 0; _i < 2; ++_i) nvoffA[_h][_i] = voffA[_h][_i]; } }
#pragma unroll 1
        for (int t = 0; t < nt; t += 2) {
            const bool last = (t == nt - 2), post = (t == 0) && (ui > 0);
            const char* a1 = cA + (size_t)(t + 1) * kstep;
            const char* a2 = last ? nA : cA + (size_t)(t + 2) * kstep; const char* b2 = last ? nB : cB + (size_t)(t + 2) * kstep;
            const char* a3 = a2 + kstep; const char* b3 = b2 + kstep;
            if constexpr (GATHER) { if (last && has_next) PG8_RM_READ(nvoffA, nxt); }
            PG8_LDB(B0, 0, 0); PG8_LDB(B1, 0, 1); PG8_SCHED; PG8_LDA(At, 0, 0); PG8_STAGE_A(PG8_SA(1, 1), a1, 1, false);
            PG8_WAIT_VP(post); PG8_WAIT_L(0); PG8_BAR; PG8_MMA(0, 0, At, B0); PG8_MMA(0, 1, At, B1); PG8_BAR; PG8_SCHED;
            PG8_LDA(At, 0, 1); PG8_STAGE_B(PG8_SB(0, 0), b2); PG8_STAGE_B(PG8_SB(0, 1), b2 + hstepB); PG8_STAGE_A(PG8_SA(0, 0), a2, 0, last);
            PG8_WAIT_VP(post); PG8_WAIT_L(0); PG8_BAR; PG8_MMA(1, 0, At, B0); PG8_MMA(1, 1, At, B1); PG8_BAR; PG8_SCHED;
            PG8_LDB(B0, 1, 0); PG8_LDB(B1, 1, 1); PG8_SCHED; PG8_LDA(At, 1, 0); PG8_STAGE_A(PG8_SA(0, 1), a2, 1, last);
            PG8_WAIT_V(8); PG8_WAIT_L(0); PG8_BAR; PG8_MMA(0, 0, At, B0); PG8_MMA(0, 1, At, B1); PG8_BAR; PG8_SCHED;
            PG8_LDA(At, 1, 1); PG8_STAGE_B(PG8_SB(1, 0), b3); PG8_STAGE_B(PG8_SB(1, 1), b3 + hstepB); PG8_STAGE_A(PG8_SA(1, 0), a3, 0, last);
            PG8_WAIT_V(8); PG8_WAIT_L(0); PG8_BAR; PG8_MMA(1, 0, At, B0); PG8_MMA(1, 1, At, B1); PG8_BAR; PG8_SCHED;
        }
        if (wr == 0) PG8_BAR;
        if constexpr (FP8) asm volatile("s_nop 15\n\ts_nop 15" ::: "memory");
        E(acc, cur, wr, wc, fr, fq);
        if (!has_next) break;
#pragma unroll
        for (int a = 0; a < 2; ++a)
#pragma unroll
            for (int b = 0; b < 2; ++b)
#pragma unroll
                for (int m = 0; m < 4; ++m)
#pragma unroll
                    for (int n = 0; n < 2; ++n) { acc[a][b][m][n] = (f32x4){0.f, 0.f, 0.f, 0.f}; }
        cur = nxt; cA = nA; cB = nB; ++ui;
        if constexpr (GATHER) {
#pragma unroll
            for (int _h = 0; _h < 2; ++_h)
#pragma unroll
                for (int _i = 0; _i < 2; ++_i) voffA[_h][_i] = nvoffA[_h][_i]; }
        if (wr == 1) PG8_BAR;
    }
    PG8_WAIT_V(0);
    PG8_BAR;
#undef PG8_SA
#undef PG8_SB
#undef PG8_STAGE_A
#undef PG8_STAGE_B
#undef PG8_LDA
#undef PG8_LDB
#undef PG8_MMA
#undef PG8_WAIT_V
#undef PG8_WAIT_L
#undef PG8_WAIT_VP
#undef PG8_BAR
#undef PG8_SCHED
#undef PG8_GOFF
#undef PG8_RM_ISSUE
#undef PG8_RM_READ
}

struct DenseSched {
    const char* A; const char* B; int lda, ldb, nM, nN, nwg, G, c;
    __device__ __forceinline__ void init(const void* A_, int lda_, int nM_, const void* B_, int ldb_, int nN_, int G_, int c_) { A = (const char*)A_; B = (const char*)B_; lda = lda_; ldb = ldb_; nM = nM_; nN = nN_; nwg = nM * nN; G = G_; c = c_; }
    __device__ __forceinline__ bool next(int i, Unit& u) const {
        const long L = (long)i * G + c; if (L >= nwg) return false;
        int wgid = (int)L; { const int q = nwg / NXCD, r = nwg % NXCD, xcd = wgid % NXCD, off = wgid / NXCD; wgid = (xcd < r ? xcd * (q + 1) : r * (q + 1) + (xcd - r) * q) + off; }
        const int nig = WGM * nN, gid = wgid / nig, fm = gid * WGM, gsz = (nM - fm) < WGM ? (nM - fm) : WGM;
        u.pm = fm + ((wgid % nig) % gsz); u.pn = (wgid % nig) / gsz; u.aux = 0; u.rowmap = nullptr; u.nvalid = 256;
        u.A = A + (size_t)u.pm * 256 * lda * 2; u.B = B + (size_t)u.pn * 256 * ldb * 2; return true;
    }
};
struct BatchSched {
    const char* A; const char* B; size_t sA, sB; int lda, ldb, nM, nN, nb, G, c;
    __device__ __forceinline__ bool next(int i, Unit& u) const {
        const int L = i * G + c; const int per = nM * nN; if (L >= nb * per) return false;
        const int g = L / per, r = L % per; u.aux = g; u.pm = r / nN; u.pn = r % nN; u.rowmap = nullptr; u.nvalid = 256;
        u.A = A + (size_t)g * sA + (size_t)u.pm * 256 * lda * 2; u.B = B + (size_t)g * sB + (size_t)u.pn * 256 * ldb * 2; return true;
    }
};
struct MoeSched {
    const LAS int* tb; const LAS int* cnt; const char* A; const char* B; size_t sB; const int* list; int lda, ldb, nN, G, c; bool gather;
    __device__ __forceinline__ bool next(int i, Unit& u) const {
        const int L = i * G + c; const int T = tb[NE]; if (L >= T * nN) return false;
        const int tile = L / nN; u.pn = L % nN; int e = 0;
        e = (int)((const LAS unsigned char*)tb)[LC_TE - LC_TB + tile];
        const int mt = tile - tb[e]; u.aux = e; u.pm = tile;
        u.B = B + (size_t)e * sB + (size_t)u.pn * 256 * ldb * 2;
        if (gather) { u.A = A; u.rowmap = list + (size_t)e * ROWS + mt * 256; int nv = cnt[e] - mt * 256; u.nvalid = nv > 256 ? 256 : nv; }
        else { u.A = A + (size_t)tile * 256 * lda * 2; u.rowmap = nullptr; u.nvalid = 256; }
        return true;
    }
};
}

#define EPI_LOOP for (int ai = 0; ai < 2; ++ai) _Pragma("unroll") for (int m = 0; m < 4; ++m) _Pragma("unroll") for (int bj = 0; bj < 2; ++bj)
struct EpiInProj {
    static constexpr int NST = 16;
    bf16_t* Z; bf16_t* UPX;
    __device__ __forceinline__ void operator()(const f32x4 (&acc)[2][2][4][2], const pg8::Unit& u, int wr, int wc, int fr, int fq) const {
        const bool isu = (u.pn == 10 || u.pn == 11);
#pragma unroll
        EPI_LOOP {
            const int r = u.pm * 256 + ai * 128 + wr * 64 + m * 16 + fr, c = u.pn * 256 + bj * 128 + wc * 32 + 8 * fq;
            const f32x4 v0 = acc[ai][bj][m][0], v1 = acc[ai][bj][m][1];
            u32x4 w; w.x = cvt_pk_bf16(v0[0], v0[1]); w.y = cvt_pk_bf16(v0[2], v0[3]); w.z = cvt_pk_bf16(v1[0], v1[1]); w.w = cvt_pk_bf16(v1[2], v1[3]);
            if (isu) { const int cu = c - ZC_U, g = cu >> 4, cc = cu & 15; *(u32x4*)(UPX + ((size_t)(g * 512 + (r >> 5)) * 768 + (r & 31) * 16 + cc)) = w; }
            else *(u32x4*)(Z + (size_t)r * INC + c) = w;
        }
    }
};
__device__ __forceinline__ void ld8_bf16(const bf16_t* p, f32x4& a, f32x4& b) { const bf16x8 v = *(const bf16x8*)p; a = (f32x4){bfs2f(v[0]), bfs2f(v[1]), bfs2f(v[2]), bfs2f(v[3])}; b = (f32x4){bfs2f(v[4]), bfs2f(v[5]), bfs2f(v[6]), bfs2f(v[7])}; }
__device__ __forceinline__ void st8_bf16(bf16_t* p, const f32x4 a, const f32x4 b) { u32x4 w; w.x = cvt_pk_bf16(a[0], a[1]); w.y = cvt_pk_bf16(a[2], a[3]); w.z = cvt_pk_bf16(b[0], b[1]); w.w = cvt_pk_bf16(b[2], b[3]); *(u32x4*)p = w; }
struct EpiOut {
    static constexpr int NST = 16;
    const float* xc; const float* xl; const bf16_t* xb; bf16_t* X1; const float* modl; int row0; int accum;
    __device__ __forceinline__ void operator()(const f32x4 (&acc)[2][2][4][2], const pg8::Unit& u, int wr, int wc, int fr, int fq) const {
        f32x4 gg[2][2];
#pragma unroll
        for (int bj = 0; bj < 2; ++bj) { const float* g1 = modl + ((row0 + u.pm * 256) < CTXL ? 12288 : 0) + 2 * 2048 + u.pn * 256 + bj * 128 + wc * 32 + 8 * fq; gg[bj][0] = *(const f32x4*)g1; gg[bj][1] = *(const f32x4*)(g1 + 4); }
#pragma unroll
        for (int ai = 0; ai < 2; ++ai)
#pragma unroll
        for (int mh = 0; mh < 2; ++mh) {
            f32x4 xx[2][2][2];
#pragma unroll
            for (int ml = 0; ml < 2; ++ml)
#pragma unroll
                for (int bj = 0; bj < 2; ++bj) { const int r = row0 + u.pm * 256 + ai * 128 + wr * 64 + (mh * 2 + ml) * 16 + fr, c = u.pn * 256 + bj * 128 + wc * 32 + 8 * fq;
                    if (accum) ld8_bf16(X1 + (size_t)r * D + c, xx[ml][bj][0], xx[ml][bj][1]);
                    else if (xb) ld8_bf16(xb + (size_t)r * D + c, xx[ml][bj][0], xx[ml][bj][1]);
                    else { const float* xin = (r < CTXL ? xc : xl) + (size_t)r * D + c; xx[ml][bj][0] = *(const f32x4*)xin; xx[ml][bj][1] = *(const f32x4*)(xin + 4); } }
#pragma unroll
            for (int ml = 0; ml < 2; ++ml)
#pragma unroll
                for (int bj = 0; bj < 2; ++bj) { const int m = mh * 2 + ml; const int r = row0 + u.pm * 256 + ai * 128 + wr * 64 + m * 16 + fr, c = u.pn * 256 + bj * 128 + wc * 32 + 8 * fq;
                    st8_bf16(X1 + (size_t)r * D + c, xx[ml][bj][0] + gg[bj][0] * (acc[ai][bj][m][0] * W8_INV), xx[ml][bj][1] + gg[bj][1] * (acc[ai][bj][m][1] * W8_INV)); }
        }
    }
};
struct EpiGateUp {
    static constexpr int NST = 16;
    unsigned char* H; const float* bgu;
    __device__ __forceinline__ void operator()(const f32x4 (&acc)[2][2][4][2], const pg8::Unit& u, int wr, int wc, int fr, int fq) const {
        f32x4 bb[2][2];
#pragma unroll
        for (int bj = 0; bj < 2; ++bj) { const float* b = bgu + u.aux * 2048 + u.pn * 256 + bj * 128 + wc * 32 + 8 * fq; bb[bj][0] = *(const f32x4*)b; bb[bj][1] = *(const f32x4*)(b + 4); }
#pragma unroll
        EPI_LOOP {
            const int r = u.pm * 256 + ai * 128 + wr * 64 + m * 16 + fr, c = u.pn * 256 + bj * 128 + wc * 32 + 8 * fq;
            const f32x4 v0 = acc[ai][bj][m][0] * W8_INV + bb[bj][0], v1 = acc[ai][bj][m][1] * W8_INV + bb[bj][1];
            float o[4];
#pragma unroll
            for (int q = 0; q < 4; ++q) { const float gt = fminf(q < 2 ? v0[2 * q] : v1[2 * q - 4], 7.f); const float up = fminf(fmaxf(q < 2 ? v0[2 * q + 1] : v1[2 * q - 3], -7.f), 7.f);
                o[q] = (up + 1.f) * gt * sigmoid_(gt * 1.702f); }
            *(unsigned*)(H + (size_t)r * DE + (c >> 1)) = pk4_fp8(o[0], o[1], o[2], o[3]);
        }
    }
};
struct EpiDown {
    static constexpr int NST = 16;
    bf16_t* Y; const float* bd;
    __device__ __forceinline__ void operator()(const f32x4 (&acc)[2][2][4][2], const pg8::Unit& u, int wr, int wc, int fr, int fq) const {
        f32x4 bb[2][2];
#pragma unroll
        for (int bj = 0; bj < 2; ++bj) { const float* b = bd + u.aux * 2048 + u.pn * 256 + bj * 128 + wc * 32 + 8 * fq; bb[bj][0] = *(const f32x4*)b; bb[bj][1] = *(const f32x4*)(b + 4); }
#pragma unroll
        EPI_LOOP {
            const int r = u.pm * 256 + ai * 128 + wr * 64 + m * 16 + fr, c = u.pn * 256 + bj * 128 + wc * 32 + 8 * fq;
            const f32x4 v0 = acc[ai][bj][m][0] * W8_INV + bb[bj][0], v1 = acc[ai][bj][m][1] * W8_INV + bb[bj][1];
            u32x4 w; w.x = cvt_pk_bf16(v0[0], v0[1]); w.y = cvt_pk_bf16(v0[2], v0[3]); w.z = cvt_pk_bf16(v1[0], v1[1]); w.w = cvt_pk_bf16(v1[2], v1[3]);
            *(u32x4*)(Y + (size_t)r * D + c) = w;
        }
    }
};
struct EpiS1 {
    static constexpr int NST = 32;
    float* E;
    __device__ __forceinline__ void operator()(const f32x4 (&acc)[2][2][4][2], const pg8::Unit& u, int wr, int wc, int fr, int fq) const {
#pragma unroll
        EPI_LOOP {
            const int r = u.pm * 256 + ai * 128 + wr * 64 + m * 16 + fr, c = bj * 128 + wc * 32 + 8 * fq;
            float* p = E + ((size_t)u.aux * 512 + r) * 256 + c; *(f32x4*)p = acc[ai][bj][m][0]; *(f32x4*)(p + 4) = acc[ai][bj][m][1];
        }
    }
};
struct EpiS3 {
    static constexpr int NST = 0;
    bf16_t* YG;
    __device__ __forceinline__ void operator()(const f32x4 (&acc)[2][2][4][2], const pg8::Unit& u, int wr, int wc, int fr, int fq) const {
#pragma unroll
        EPI_LOOP {
            const int j = u.pm * 256 + ai * 128 + wr * 64 + m * 16 + fr, n = u.pn * 256 + bj * 128 + wc * 32 + 8 * fq;
            if (j < NCH) { const f32x4 v0 = acc[ai][bj][m][0], v1 = acc[ai][bj][m][1];
                u32x4 w; w.x = cvt_pk_bf16(gelu_tanh_(v0[0]), gelu_tanh_(v0[1])); w.y = cvt_pk_bf16(gelu_tanh_(v0[2]), gelu_tanh_(v0[3]));
                w.z = cvt_pk_bf16(gelu_tanh_(v1[0]), gelu_tanh_(v1[1])); w.w = cvt_pk_bf16(gelu_tanh_(v1[2]), gelu_tanh_(v1[3]));
                *(u32x4*)(YG + (size_t)(32 * j + (n >> 4)) * 512 + 16 * u.aux + (n & 15)) = w; }
        }
    }
};
struct EpiGLU {
    static constexpr int NST = 16;
    const bf16_t* YG; unsigned char* MIX8; const float* bglu;
    __device__ __forceinline__ void operator()(const f32x4 (&acc)[2][2][4][2], const pg8::Unit& u, int wr, int wc, int fr, int fq) const {
        f32x4 bb[2][2];
#pragma unroll
        for (int bj = 0; bj < 2; ++bj) { const float* b = bglu + u.pn * 256 + bj * 128 + wc * 32 + 8 * fq; bb[bj][0] = *(const f32x4*)b; bb[bj][1] = *(const f32x4*)(b + 4); }
#pragma unroll
        for (int ai = 0; ai < 2; ++ai) {
        bf16x8 yy[4][2];
#pragma unroll
        for (int m = 0; m < 4; ++m)
#pragma unroll
            for (int bj = 0; bj < 2; ++bj) yy[m][bj] = *(const bf16x8*)(YG + (size_t)(u.pm * 256 + ai * 128 + wr * 64 + m * 16 + fr) * 512 + u.pn * 256 + bj * 128 + wc * 32 + 8 * fq);
#pragma unroll
        for (int m = 0; m < 4; ++m)
#pragma unroll
        for (int bj = 0; bj < 2; ++bj) {
            const int r = u.pm * 256 + ai * 128 + wr * 64 + m * 16 + fr, c = u.pn * 256 + bj * 128 + wc * 32 + 8 * fq;
            const bf16x8 y = yy[m][bj];
            const f32x4 v0 = acc[ai][bj][m][0] + bb[bj][0], v1 = acc[ai][bj][m][1] + bb[bj][1];
            u32x2 w; w.x = pk4_fp8(bfs2f(y[0]) * sigmoid_(v0[0]), bfs2f(y[1]) * sigmoid_(v0[1]), bfs2f(y[2]) * sigmoid_(v0[2]), bfs2f(y[3]) * sigmoid_(v0[3]));
            w.y = pk4_fp8(bfs2f(y[4]) * sigmoid_(v1[0]), bfs2f(y[5]) * sigmoid_(v1[1]), bfs2f(y[6]) * sigmoid_(v1[2]), bfs2f(y[7]) * sigmoid_(v1[3]));
            *(u32x2*)(MIX8 + (size_t)r * D + 1536 + c) = w;
        }
        }
    }
};

namespace att {
constexpr int DH = 128, NW = 8, QBLK = 32, KVBLK = 64;
constexpr float SCALE = 0.088388347648318440f;
constexpr float THR = 8.f;
constexpr int LDQ = INC, LDK = INC, LDO = 512;
constexpr size_t SHM_V = KVBLK * DH * 2, SHM_K = KVBLK * DH * 2, SHM_ATTN = 2 * SHM_V + 2 * SHM_K + NW * 64 * 4;
#define KSWZ(row, colB) ((row) * 256 + ((colB) ^ (((row) & 7) << 4)))
#define SBAR() __builtin_amdgcn_sched_barrier(0)
__device__ __forceinline__ int crow(int r, int hi) { return (r & 3) + 8 * (r >> 2) + 4 * hi; }
__device__ __forceinline__ unsigned cvtpk(float lo, float hi) { unsigned r; asm volatile("v_cvt_pk_bf16_f32 %0, %1, %2" : "=v"(r) : "v"(lo), "v"(hi)); return r; }
__device__ __forceinline__ void partialSM(f32x16& p0, f32x16& p1, float& m_reg, float& mn, float& alpha) {
  constexpr float C = SCALE * 1.4426950408889634f;
  float pmax = p0[0];
#pragma unroll
  for (int r = 1; r < 16; ++r) pmax = fmaxf(pmax, p0[r]);
#pragma unroll
  for (int r = 0; r < 16; ++r) pmax = fmaxf(pmax, p1[r]);
  { auto rr = __builtin_amdgcn_permlane32_swap(__float_as_uint(pmax), __float_as_uint(pmax), false, false);
    pmax = fmaxf(__uint_as_float(rr[0]), __uint_as_float(rr[1])); }
  if (__builtin_expect(__all(pmax - m_reg <= THR / SCALE), 1)) { mn = m_reg; alpha = 1.f; }
  else { mn = fmaxf(m_reg, pmax); alpha = __builtin_amdgcn_exp2f((m_reg - mn) * C); m_reg = mn; }
  float mnC = -mn * C;
#pragma unroll
  for (int r = 0; r < 16; ++r) p0[r] = fmaf(p0[r], C, mnC);
#pragma unroll
  for (int r = 0; r < 16; ++r) p1[r] = fmaf(p1[r], C, mnC);
#pragma unroll
  for (int r = 0; r < 16; ++r) p0[r] = __builtin_amdgcn_exp2f(p0[r]);
}
__device__ __forceinline__ void finishSM(f32x16& p0, f32x16& p1, float alpha, float& l_reg, bf16x8& pa0, bf16x8& pa1, bf16x8& pa2, bf16x8& pa3) {
#pragma unroll
  for (int r = 0; r < 16; ++r) p1[r] = __builtin_amdgcn_exp2f(p1[r]);
  float ps = 0;
#pragma unroll
  for (int r = 0; r < 16; ++r) ps += p0[r];
#pragma unroll
  for (int r = 0; r < 16; ++r) ps += p1[r];
  { auto rr = __builtin_amdgcn_permlane32_swap(__float_as_uint(ps), __float_as_uint(ps), false, false);
    ps = __uint_as_float(rr[0]) + __uint_as_float(rr[1]); }
  l_reg = l_reg * alpha + ps;
#define PK4(P, BASE, OUT) do { unsigned a0 = cvtpk(P[BASE + 0], P[BASE + 1]), a1 = cvtpk(P[BASE + 2], P[BASE + 3]);   \
    unsigned b0 = cvtpk(P[BASE + 4], P[BASE + 5]), b1 = cvtpk(P[BASE + 6], P[BASE + 7]);                              \
    auto r0 = __builtin_amdgcn_permlane32_swap(a0, b0, false, false); auto r1 = __builtin_amdgcn_permlane32_swap(a1, b1, false, false); \
    u32x4 w = {r0[0], r1[0], r0[1], r1[1]}; OUT = __builtin_bit_cast(bf16x8, w); } while (0)
  PK4(p0, 0, pa0); PK4(p0, 8, pa1); PK4(p1, 0, pa2); PK4(p1, 8, pa3);
#undef PK4
}
__device__ __forceinline__ void qkt(f32x16& p0, f32x16& p1, const bf16_t* Ks, const bf16x8* qr, int r32, int hi) {
  p0 = f32x16{}; p1 = f32x16{};
#pragma unroll
  for (int d0 = 0; d0 < 8; ++d0) { int cb = (d0 * 16 + hi * 8) * 2;
    bf16x8 b0 = *reinterpret_cast<const bf16x8*>((const char*)Ks + KSWZ(r32, cb));
    bf16x8 b1 = *reinterpret_cast<const bf16x8*>((const char*)Ks + KSWZ(32 + r32, cb));
    p0 = __builtin_amdgcn_mfma_f32_32x32x16_bf16(b0, qr[d0], p0, 0, 0, 0);
    p1 = __builtin_amdgcn_mfma_f32_32x32x16_bf16(b1, qr[d0], p1, 0, 0, 0); }
}
__device__ __forceinline__ int v_st(int k, int c) { const int kk = (k & ~0xC) | ((k & 4) << 1) | ((k & 8) >> 1); return ((kk >> 3) * 4 + (c >> 5)) * 512 + ((kk & 7) * 32 + (c & 31)) * 2; }
__device__ __forceinline__ int v_rd_base(int lane) { return ((lane & 3) << 3) | (((lane >> 2) & 3) << 6) | (((lane >> 4) & 1) << 5) | (((lane >> 5) & 1) << 8); }
constexpr int v_rd_off(int d0, int ks, int half) { return d0 * 512 + ks * 4096 + half * 2048; }
template <int OFF> __device__ __forceinline__ s16x4 tr_read(int vb) {
  s16x4 r; asm volatile("ds_read_b64_tr_b16 %0, %1 offset:%2" : "=&v"(r) : "v"(vb), "i"(OFF) : "memory"); return r;
}
template <int D0> __device__ __forceinline__ void pv_one(f32x16& od, int vb, bf16x8 pa0, bf16x8 pa1, bf16x8 pa2, bf16x8 pa3) {
  const s16x4 l0 = tr_read<v_rd_off(D0, 0, 0)>(vb), h0 = tr_read<v_rd_off(D0, 0, 1)>(vb), l1 = tr_read<v_rd_off(D0, 1, 0)>(vb), h1 = tr_read<v_rd_off(D0, 1, 1)>(vb);
  const s16x4 l2 = tr_read<v_rd_off(D0, 2, 0)>(vb), h2 = tr_read<v_rd_off(D0, 2, 1)>(vb), l3 = tr_read<v_rd_off(D0, 3, 0)>(vb), h3 = tr_read<v_rd_off(D0, 3, 1)>(vb);
  asm volatile("s_waitcnt lgkmcnt(0)" ::: "memory"); SBAR();
#define PK(L, H) (bf16x8){L[0], L[1], L[2], L[3], H[0], H[1], H[2], H[3]}
  od = __builtin_amdgcn_mfma_f32_32x32x16_bf16(pa0, PK(l0, h0), od, 0, 0, 0);
  od = __builtin_amdgcn_mfma_f32_32x32x16_bf16(pa1, PK(l1, h1), od, 0, 0, 0);
  od = __builtin_amdgcn_mfma_f32_32x32x16_bf16(pa2, PK(l2, h2), od, 0, 0, 0);
  od = __builtin_amdgcn_mfma_f32_32x32x16_bf16(pa3, PK(l3, h3), od, 0, 0, 0);
#undef PK
}
__device__ __forceinline__ void pv_d0(f32x16* o, int vb, bf16x8 pa0, bf16x8 pa1, bf16x8 pa2, bf16x8 pa3) {
  pv_one<0>(o[0], vb, pa0, pa1, pa2, pa3); pv_one<1>(o[1], vb, pa0, pa1, pa2, pa3); pv_one<2>(o[2], vb, pa0, pa1, pa2, pa3); pv_one<3>(o[3], vb, pa0, pa1, pa2, pa3);
}
template <bool PIGGY>
__device__ __forceinline__ void attn_dense_body(const bf16_t* __restrict__ Qb, const bf16_t* __restrict__ Kh, const bf16_t* __restrict__ Vh,
                                                float* __restrict__ Ob, float* __restrict__ MLb, int seq, char* lds, const PgA PG = PgA{}) {
  const int tid = opaque_tid(), wid = tid >> 6, lane = tid & 63, r32 = lane & 31, hi = lane >> 5;
  const int wid_u = __builtin_amdgcn_readfirstlane(wid); LAS char* lds_las = (LAS char*)lds; (void)wid_u; (void)lds_las;
  bf16_t* V_lds = (bf16_t*)lds; bf16_t* K_lds = (bf16_t*)(lds + 2 * SHM_V);
  float* ws = (float*)(lds + 2 * SHM_V + 2 * SHM_K) + wid * 64; float* li_l = ws; float* al_l = ws + 32;
  float m_reg = -1e30f, l_reg = 0; f32x16 o[4] = {}; bf16x8 qr[8];
  const bf16_t* Qw = Qb + (long)(wid * QBLK + r32) * LDQ + hi * 8;
#pragma unroll
  for (int d0 = 0; d0 < 8; ++d0) qr[d0] = *reinterpret_cast<const bf16x8*>(Qw + d0 * 16);
  const int sr = tid >> 4, sc = (tid & 15) * 8, vst0 = v_st(sr, sc), vst1 = v_st(32 + sr, sc);
  const int vb0 = (int)(uintptr_t)V_lds + v_rd_base(lane);
  bf16x8 s0_vs0, s0_vs1, s0_ks0, s0_ks1, s1_vs0, s1_vs1, s1_ks0, s1_ks1;
#define SLOAD0(k0) do { s0_vs0 = *(const bf16x8*)(&Vh[(long)((k0) + sr) * LDK + sc]); s0_vs1 = *(const bf16x8*)(&Vh[(long)((k0) + 32 + sr) * LDK + sc]); \
    s0_ks0 = *(const bf16x8*)(&Kh[(long)((k0) + sr) * LDK + sc]); s0_ks1 = *(const bf16x8*)(&Kh[(long)((k0) + 32 + sr) * LDK + sc]); } while (0)
#define SLOAD1(k0) do { s1_vs0 = *(const bf16x8*)(&Vh[(long)((k0) + sr) * LDK + sc]); s1_vs1 = *(const bf16x8*)(&Vh[(long)((k0) + 32 + sr) * LDK + sc]); \
    s1_ks0 = *(const bf16x8*)(&Kh[(long)((k0) + sr) * LDK + sc]); s1_ks1 = *(const bf16x8*)(&Kh[(long)((k0) + 32 + sr) * LDK + sc]); } while (0)
#define SWRITE0(b) do { *(bf16x8*)((char*)V_lds + (b) * SHM_V + vst0) = s0_vs0; *(bf16x8*)((char*)V_lds + (b) * SHM_V + vst1) = s0_vs1; int kc = sc * 2; \
    *(bf16x8*)((char*)K_lds + (b) * SHM_K + KSWZ(sr, kc)) = s0_ks0; *(bf16x8*)((char*)K_lds + (b) * SHM_K + KSWZ(32 + sr, kc)) = s0_ks1; } while (0)
#define SWRITE1(b) do { *(bf16x8*)((char*)V_lds + (b) * SHM_V + vst0) = s1_vs0; *(bf16x8*)((char*)V_lds + (b) * SHM_V + vst1) = s1_vs1; int kc = sc * 2; \
    *(bf16x8*)((char*)K_lds + (b) * SHM_K + KSWZ(sr, kc)) = s1_ks0; *(bf16x8*)((char*)K_lds + (b) * SHM_K + KSWZ(32 + sr, kc)) = s1_ks1; } while (0)
#define SWAIT() asm volatile("s_waitcnt vmcnt(4)" ::: "memory")
#define RESC(a) do { if (__any((a) < 1.f)) { if (hi == 0) al_l[r32] = (a); asm volatile("s_waitcnt lgkmcnt(0)" ::: "memory"); \
    _Pragma("unroll") for (int d = 0; d < 4; ++d) _Pragma("unroll") for (int r = 0; r < 16; ++r) o[d][r] *= al_l[crow(r, hi)]; } } while (0)
  f32x16 pA0, pA1, pB0, pB1; float mnA, mnB, alA, alB; bf16x8 pa0, pa1, pa2, pa3; const int NT = seq / KVBLK;
  SLOAD0(0); asm volatile("s_waitcnt vmcnt(0)" ::: "memory"); SWRITE0(0); __syncthreads();
  qkt(pA0, pA1, K_lds, qr, r32, hi); partialSM(pA0, pA1, m_reg, mnA, alA);
  SLOAD1(KVBLK); if (2 < NT) SLOAD0(2 * KVBLK);
#define PGA_P1(sidx) do { if constexpr (PIGGY) { if ((sidx) <= PGA_NI + 1) pga_rb(PG, (LAS unsigned char*)(LAS char*)lds_las, (sidx), PGA_NI, wid_u); } } while (0)
#define PGA_P2(sidx) do { if constexpr (PIGGY) { if ((sidx) <= PGA_NI) pga_ci(PG, (LAS unsigned char*)(LAS char*)lds_las, (sidx), PGA_NI, wid_u); } } while (0)
  SWAIT(); SWRITE1(1); __syncthreads();
  for (int j = 1; j + 1 < NT; j += 2) {
    PGA_P2(j - 1);
    SBAR(); qkt(pB0, pB1, (bf16_t*)((char*)K_lds + SHM_K), qr, r32, hi);
    finishSM(pA0, pA1, alA, l_reg, pa0, pa1, pa2, pa3); SBAR();
    SLOAD1((j + 2) * KVBLK); SBAR();
    pv_d0(o, vb0, pa0, pa1, pa2, pa3); partialSM(pB0, pB1, m_reg, mnB, alB);
    __syncthreads(); SWAIT(); SWRITE0(0); PGA_P1(j);
    RESC(alB); __syncthreads();
    PGA_P2(j);
    SBAR(); qkt(pA0, pA1, K_lds, qr, r32, hi);
    finishSM(pB0, pB1, alB, l_reg, pa0, pa1, pa2, pa3); SBAR();
    if (j + 3 < NT) SLOAD0((j + 3) * KVBLK); SBAR();
    pv_d0(o, vb0 + (int)SHM_V, pa0, pa1, pa2, pa3); partialSM(pA0, pA1, m_reg, mnA, alA);
    __syncthreads(); SWAIT(); SWRITE1(1); if constexpr (PIGGY) { if (j + 3 >= NT) asm volatile("s_waitcnt vmcnt(0)" ::: "memory"); } PGA_P1(j + 1);
    RESC(alA); __syncthreads();
  }
  SBAR(); qkt(pB0, pB1, (bf16_t*)((char*)K_lds + SHM_K), qr, r32, hi);
  finishSM(pA0, pA1, alA, l_reg, pa0, pa1, pa2, pa3); SBAR();
  pv_d0(o, vb0, pa0, pa1, pa2, pa3); partialSM(pB0, pB1, m_reg, mnB, alB);
  __syncthreads(); RESC(alB);
  finishSM(pB0, pB1, alB, l_reg, pa0, pa1, pa2, pa3); SBAR();
  pv_d0(o, vb0 + (int)SHM_V, pa0, pa1, pa2, pa3);
  if (hi == 0) { li_l[r32] = l_reg; MLb[(wid * QBLK + r32) * 8 + 0] = m_reg; MLb[(wid * QBLK + r32) * 8 + 1] = l_reg; }
  asm volatile("s_waitcnt lgkmcnt(0)" ::: "memory");
  float rli[16];
#pragma unroll
  for (int r = 0; r < 16; ++r) rli[r] = __builtin_amdgcn_rcpf(li_l[crow(r, hi)]);
  float* Ow = Ob + (long)(wid * QBLK) * LDO;
#pragma unroll
  for (int r = 0; r < 16; ++r) { int orow = crow(r, hi);
#pragma unroll
    for (int d0 = 0; d0 < 4; ++d0) Ow[(long)orow * LDO + d0 * 32 + r32] = o[d0][r] * rli[r]; }
  if constexpr (PIGGY) {
    asm volatile("s_waitcnt vmcnt(0)" ::: "memory"); __syncthreads(); PGA_P2(NT - 2); asm volatile("s_waitcnt lgkmcnt(0)" ::: "memory"); __syncthreads(); PGA_P1(NT - 1);
  }
#undef PGA_P1
#undef PGA_P2
  __syncthreads();
#undef SLOAD0
#undef SLOAD1
#undef SWRITE0
#undef SWRITE1
#undef SWAIT
#undef RESC
}
}

__device__ __forceinline__ void ret_out_unit(LAS unsigned char* lds, unsigned char* ws, const int b, const int h) {
#define Z ((bf16_t*)(ws + WS_Z))
#define SPREV ((bf16_t*)(ws + WS_SPREV))
#define MIX ((bf16_t*)(ws + WS_MIX))
                const int tid = opaque_tid(), lane = tid & 63, wave = __builtin_amdgcn_readfirstlane(tid >> 6), fr = lane & 15, fq = lane >> 4;
                LAS unsigned char* Qs = lds; LAS unsigned char* Ks = lds + 34816; LAS unsigned char* VT = lds + 69632;
                const float l2gf = log2f(1.f - __builtin_amdgcn_exp2f(-5.f - (float)h)), l2gb = log2f(1.f - __builtin_amdgcn_exp2f(-5.f - (float)(3 - h)));
                {
                    const int j = tid >> 2, sub = tid & 3, row = b * 128 + j; const bf16_t* zr = Z + (size_t)row * INC;
                    const bool lat = row >= CTXL; const float tpos = (float)(row - CTXL);
#pragma unroll
                    for (int h8 = 0; h8 < 2; ++h8) { const int dk0 = 16 * sub + 8 * h8;
                        const bf16x8 q1 = *(const bf16x8*)(zr + ZC_RQ + h * 128 + dk0), q2 = *(const bf16x8*)(zr + ZC_RQ + h * 128 + 64 + dk0);
                        const bf16x8 k1 = *(const bf16x8*)(zr + ZC_RK + h * 128 + dk0), k2 = *(const bf16x8*)(zr + ZC_RK + h * 128 + 64 + dk0);
                        float qa[8], qb_[8], ka[8], kb_[8];
#pragma unroll
                        for (int e = 0; e < 8; ++e) { const int dk = dk0 + e; float a1 = bfs2f(q1[e]), a2 = bfs2f(q2[e]), b1 = bfs2f(k1[e]), b2 = bfs2f(k2[e]);
                            if (lat) { const float freq = __builtin_amdgcn_exp2f(-(float)dk * (LOG2_1E4 / 64.f)); float sn, cs; sincos_ang(tpos * freq, sn, cs);
                                const float t1 = a1 * cs - a2 * sn, t2 = a1 * sn + a2 * cs, t3 = b1 * cs - b2 * sn, t4 = b1 * sn + b2 * cs; a1 = t1; a2 = t2; b1 = t3; b2 = t4; }
                            qa[e] = a1; qb_[e] = a2; ka[e] = b1 * 0.08838834764831845f; kb_[e] = b2 * 0.08838834764831845f; }
                        u32x4 w;
                        w.x = cvt_pk_bf16(qa[0], qa[1]); w.y = cvt_pk_bf16(qa[2], qa[3]); w.z = cvt_pk_bf16(qa[4], qa[5]); w.w = cvt_pk_bf16(qa[6], qa[7]); *(LAS u32x4*)(Qs + j * 272 + dk0 * 2) = w;
                        w.x = cvt_pk_bf16(qb_[0], qb_[1]); w.y = cvt_pk_bf16(qb_[2], qb_[3]); w.z = cvt_pk_bf16(qb_[4], qb_[5]); w.w = cvt_pk_bf16(qb_[6], qb_[7]); *(LAS u32x4*)(Qs + j * 272 + (dk0 + 64) * 2) = w;
                        w.x = cvt_pk_bf16(ka[0], ka[1]); w.y = cvt_pk_bf16(ka[2], ka[3]); w.z = cvt_pk_bf16(ka[4], ka[5]); w.w = cvt_pk_bf16(ka[6], ka[7]); *(LAS u32x4*)(Ks + j * 272 + dk0 * 2) = w;
                        w.x = cvt_pk_bf16(kb_[0], kb_[1]); w.y = cvt_pk_bf16(kb_[2], kb_[3]); w.z = cvt_pk_bf16(kb_[4], kb_[5]); w.w = cvt_pk_bf16(kb_[6], kb_[7]); *(LAS u32x4*)(Ks + j * 272 + (dk0 + 64) * 2) = w; }
#pragma unroll
                    for (int q = 0; q < 4; ++q) { const bf16x8 v = *(const bf16x8*)(zr + ZC_RV + h * 128 + 32 * sub + 8 * q);
#pragma unroll
                        for (int e = 0; e < 8; ++e) *(LAS bf16_t*)(VT + (32 * sub + 8 * q + e) * 272 + j * 2) = (bf16_t)v[e]; }
                }
                __syncthreads();
                f32x4 Sx[8], QF[8], QB[8];
#pragma unroll
                for (int n = 0; n < 8; ++n) { Sx[n] = (f32x4){0.f, 0.f, 0.f, 0.f}; QF[n] = (f32x4){0.f, 0.f, 0.f, 0.f}; QB[n] = (f32x4){0.f, 0.f, 0.f, 0.f}; }
                const bf16_t* SPf = SPREV + ((size_t)(b * 4 + h) * 2) * 16384; const bf16_t* SPb = SPf + 16384;
#pragma unroll 2
                for (int k0 = 0; k0 < 128; k0 += 32) { const bf16x8 av = *(const LAS bf16x8*)(Qs + (16 * wave + fr) * 272 + (k0 + fq * 8) * 2);
#pragma unroll
                    for (int n = 0; n < 8; ++n) { const bf16x8 bk = *(const LAS bf16x8*)(Ks + (16 * n + fr) * 272 + (k0 + fq * 8) * 2);
                        const bf16x8 bf_ = *(const bf16x8*)(SPf + (16 * n + fr) * 128 + k0 + fq * 8), bb_ = *(const bf16x8*)(SPb + (16 * n + fr) * 128 + k0 + fq * 8);
                        Sx[n] = MFMA16(bk, av, Sx[n]); QF[n] = MFMA16(bf_, av, QF[n]); QB[n] = MFMA16(bb_, av, QB[n]); } }
                __syncthreads();
                const int ii = 16 * wave + fr;
#pragma unroll
                for (int n = 0; n < 8; ++n) { float pf[4], pbv[4];
#pragma unroll
                    for (int q = 0; q < 4; ++q) { const int jj = 16 * n + 4 * fq + q; const float df = (float)(ii - jj);
                        pf[q] = (ii >= jj) ? Sx[n][q] * __builtin_amdgcn_exp2f(l2gf * df) : 0.f; pbv[q] = (jj >= ii) ? Sx[n][q] * __builtin_amdgcn_exp2f(-l2gb * df) : 0.f; }
                    u32x2 w; w.x = cvt_pk_bf16(pf[0], pf[1]); w.y = cvt_pk_bf16(pf[2], pf[3]); *(LAS u32x2*)(Qs + ii * 272 + (16 * n + 4 * fq) * 2) = w;
                    w.x = cvt_pk_bf16(pbv[0], pbv[1]); w.y = cvt_pk_bf16(pbv[2], pbv[3]); *(LAS u32x2*)(Ks + ii * 272 + (16 * n + 4 * fq) * 2) = w; }
                __syncthreads();
                const float xif = __builtin_amdgcn_exp2f(l2gf * (float)(ii + 1)), xib = __builtin_amdgcn_exp2f(l2gb * (float)(128 - ii));
#pragma unroll
                for (int n = 0; n < 8; ++n) { QF[n] = QF[n] * xif; QB[n] = QB[n] * xib; }
#define YF QF
#define YBk QB
                const int row = b * 128 + ii; const bf16_t* zr = Z + (size_t)row * INC;
                s16x4 gfv[8], gbv[8];
#pragma unroll
                for (int n = 0; n < 8; ++n) { const int dv = 16 * n + 4 * fq; gfv[n] = *(const s16x4*)(zr + ZC_GF + h * 128 + dv); gbv[n] = *(const s16x4*)(zr + ZC_GB + h * 128 + dv); }
#pragma unroll
                for (int k0 = 0; k0 < 128; k0 += 32) { const bf16x8 a_f = *(const LAS bf16x8*)(Qs + (16 * wave + fr) * 272 + (k0 + fq * 8) * 2), a_b = *(const LAS bf16x8*)(Ks + (16 * wave + fr) * 272 + (k0 + fq * 8) * 2);
#pragma unroll
                    for (int n = 0; n < 8; ++n) { const bf16x8 bv = *(const LAS bf16x8*)(VT + (16 * n + fr) * 272 + (k0 + fq * 8) * 2); YF[n] = MFMA16(bv, a_f, YF[n]); YBk[n] = MFMA16(bv, a_b, YBk[n]); } }
                float sf = 0.f, sb = 0.f;
#pragma unroll
                for (int n = 0; n < 8; ++n) { sf += (YF[n][0] + YF[n][1]) + (YF[n][2] + YF[n][3]); sb += (YBk[n][0] + YBk[n][1]) + (YBk[n][2] + YBk[n][3]); }
                sf += __shfl_xor(sf, 16); sf += __shfl_xor(sf, 32); sb += __shfl_xor(sb, 16); sb += __shfl_xor(sb, 32);
                const float mf = sf * (1.f / 128.f), mb = sb * (1.f / 128.f); float vf = 0.f, vb = 0.f;
#pragma unroll
                for (int n = 0; n < 8; ++n) { YF[n] = YF[n] - mf; YBk[n] = YBk[n] - mb; vf += (YF[n][0] * YF[n][0] + YF[n][1] * YF[n][1]) + (YF[n][2] * YF[n][2] + YF[n][3] * YF[n][3]);
                    vb += (YBk[n][0] * YBk[n][0] + YBk[n][1] * YBk[n][1]) + (YBk[n][2] * YBk[n][2] + YBk[n][3] * YBk[n][3]); }
                vf += __shfl_xor(vf, 16); vf += __shfl_xor(vf, 32); vb += __shfl_xor(vb, 16); vb += __shfl_xor(vb, 32);
                const float rf = __builtin_amdgcn_rsqf(vf * (1.f / 128.f) + EPS), rb = __builtin_amdgcn_rsqf(vb * (1.f / 128.f) + EPS);
#pragma unroll
                for (int n = 0; n < 8; ++n) { const int dv = 16 * n + 4 * fq; float o[4];
#pragma unroll
                    for (int q = 0; q < 4; ++q) o[q] = silu_(bfs2f(gfv[n][q])) * YF[n][q] * rf + silu_(bfs2f(gbv[n][q])) * YBk[n][q] * rb;
                    *(unsigned*)((unsigned char*)MIX + (size_t)row * D + h * 128 + dv) = pk4_fp8(o[0], o[1], o[2], o[3]); }
                __syncthreads();
#undef YF
#undef YBk
#undef Z
#undef SPREV
#undef MIX
}

struct Args {
    const float *x, *c, *ctx, *c_ctx, *w_mod, *b_mod, *w_in, *w_out, *s5_a_re, *s5_a_im, *s5_log_step, *s5_b_re, *s5_b_im, *s5_c_re, *s5_c_im, *s5_d, *s5_w_glu, *s5_b_glu,
        *q_norm_w, *k_norm_w, *conv_w, *w_router, *b_router, *w_gate_up, *b_gate_up, *w_down, *b_down;
    float* out; unsigned char* ws; int ph_lo, ph_hi, rep, pad;
};

__device__ __forceinline__ void p0_transpose_item(const float* W, int K, int N, bf16_t* WT, LAS float* scr, int item, int lane) {
    const int nblk = N / 32, kb = item / nblk, nb = item % nblk, k0 = 64 * kb, n0 = 32 * nb;
#pragma unroll 8
    for (int i = 0; i < 32; ++i) { const int kk = 2 * i + (lane >> 5); scr[kk * 33 + (lane & 31)] = W[(size_t)(k0 + kk) * N + n0 + (lane & 31)]; }
    asm volatile("s_waitcnt lgkmcnt(0)" ::: "memory");
    const int c = lane & 7;
#pragma unroll
    for (int j = 0; j < 4; ++j) { const int n = (lane >> 3) + 8 * j; const LAS float* s = scr + (8 * c) * 33 + n;
        u32x4 o; o.x = cvt_pk_bf16(s[0 * 33], s[1 * 33]); o.y = cvt_pk_bf16(s[2 * 33], s[3 * 33]); o.z = cvt_pk_bf16(s[4 * 33], s[5 * 33]); o.w = cvt_pk_bf16(s[6 * 33], s[7 * 33]);
        *(u32x4*)(WT + (size_t)(n0 + n) * K + k0 + 8 * c) = o; }
    asm volatile("s_waitcnt lgkmcnt(0)" ::: "memory");
}

__global__ void __launch_bounds__(512, 2) mega_fwd(Args a) {
    extern __shared__ __attribute__((aligned(16))) unsigned char lds_raw[];
    LAS unsigned char* lds = (LAS unsigned char*)lds_raw;
    const int G = gridDim.x, bx = blockIdx.x;
    const int NGW = G * 8, NGT = G * 512;
    const __attribute__((address_space(4))) Args* kargs = (const __attribute__((address_space(4))) Args*)__builtin_amdgcn_kernarg_segment_ptr();
#define KA(field) (kargs->field)
    unsigned char* const ws = KA(ws);
    unsigned* ctl = (unsigned*)(ws + WS_CTL);
#define MODP ((float*)(ws + WS_MODP))
#define MOD ((float*)(ws + WS_MOD))
#define WIN ((bf16_t*)(ws + WS_WIN))
#define WOUT ((bf16_t*)(ws + WS_WOUT))
#define WGLU ((bf16_t*)(ws + WS_WGLU))
#define WGU ((bf16_t*)(ws + WS_WGU))
#define WDN ((bf16_t*)(ws + WS_WDN))
#define WRT ((bf16_t*)(ws + WS_WRT))
#define KTAB ((float*)(ws + WS_KTAB))
#define WE ((bf16_t*)(ws + WS_WE))
#define WTC ((bf16_t*)(ws + WS_WTC))
#define APOW ((float*)(ws + WS_APOW))
#define XN ((bf16_t*)(ws + WS_XN))
#define Z ((bf16_t*)(ws + WS_Z))
#define UPX ((bf16_t*)(ws + WS_UPX))
#define EB ((float*)(ws + WS_E))
#define KVT ((float*)(ws + WS_KVT))
#define SPREV ((bf16_t*)(ws + WS_SPREV))
#define OP ((float*)(ws + WS_OP))
#define ML ((float*)(ws + WS_ML))
#define YG ((bf16_t*)(ws + WS_YG))
#define MIX ((bf16_t*)(ws + WS_MIX))
#define XA ((bf16_t*)(ws + WS_XA))
#define XB ((bf16_t*)(ws + WS_XB))
#define FB ((bf16_t*)(ws + WS_F))
#define LIST ((int*)(ws + WS_LIST))
#define TOKI ((int*)(ws + WS_TOKI))
#define GATE ((float*)(ws + WS_GATE))
#define HB ((bf16_t*)(ws + WS_H))
#define YB ((bf16_t*)(ws + WS_Y))

    if (threadIdx.x < 64) ((LAS unsigned*)(lds + LDSCTL_OFF))[threadIdx.x] = 0u;
    __syncthreads();
    XcdBarrier bar; bar.bar = ctl + CW_BAR; bar.x = 0; bar.st = (volatile LAS unsigned*)(lds + LDSCTL_OFF + LC_BAR);
    if (!MK_MULTI) bar = xcd_barrier_post(ctl + CW_BAR, (volatile LAS unsigned*)(lds + LDSCTL_OFF + LC_BAR));
    const int lo = KA(ph_lo), hi = KA(ph_hi);
#ifndef PHMASK
#define PHMASK 0xFFFF
#endif
#define PHEN(n) (((PHMASK) >> (n)) & 1)
#ifndef SUBMASK
#define SUBMASK 0xFFFF
#endif
#define SUB(n) if constexpr (((SUBMASK) >> (n)) & 1)
#define IN(k) (lo <= (k) && (k) < hi)
#define PHASE_IDS int bx_o = blockIdx.x, G_o = gridDim.x; asm volatile("" : "+s"(bx_o), "+s"(G_o)); const int bx = bx_o, G = G_o, NGW = G * 8, NGT = G * 512; (void)NGW; (void)NGT; const int tid = opaque_tid(); const int lane = tid & 63, wave = __builtin_amdgcn_readfirstlane(tid >> 6); const int gw = bx * 8 + wave, gt = bx * 512 + tid; (void)lane; (void)gw; (void)gt;
#define SEAM(k) do { if (IN(k) && IN((k) + 1)) xcd_barrier(bar); } while (0)

    if (PHEN(0) && IN(0)) { PHASE_IDS
        if (bx >= G / 2) {
            const int gt = (bx - G / 2) * 512 + tid, NGT = (G - G / 2) * 512, gw = (bx - G / 2) * 8 + wave, NGW = (G - G / 2) * 8; (void)gt; (void)NGT; (void)gw; (void)NGW;
        for (int i = gt; i < 2 * 32 * 2048; i += NGT) { const int l = i / 65536, r = i % 65536, e = r / 2048, k = r % 2048;
            const float w = KA(w_router)[(size_t)l * 65536 + k * 32 + e]; const unsigned h = f2bf(w); const float lo_ = w - bf2f(h);
            WRT[(((size_t)(l * 2 + 0) * 64 + (k >> 5)) * 32 + e) * 32 + (k & 31)] = (bf16_t)h; WRT[(((size_t)(l * 2 + 1) * 64 + (k >> 5)) * 32 + e) * 32 + (k & 31)] = (bf16_t)f2bf(lo_); }
        for (int it = gw; it < 2 * 32 * 48; it += NGW) { const int l = it / (32 * 48), r = it % (32 * 48), kc = r / 48, ng = r % 48;
            const float* W = KA(w_mod) + (size_t)l * D * 12288 + (size_t)(kc * 64) * 12288 + ng * 256 + lane * 4;
            f32x4 acc0 = {0.f, 0.f, 0.f, 0.f}, acc1 = {0.f, 0.f, 0.f, 0.f};
            const float cl = silu_(KA(c)[kc * 64 + lane]), cc = silu_(KA(c_ctx)[kc * 64 + lane]);
#pragma unroll 8
            for (int k = 0; k < 64; ++k) { const f32x4 w = *(const f32x4*)(W + (size_t)k * 12288); const float s0 = __shfl(cl, k), s1 = __shfl(cc, k); acc0 += w * s0; acc1 += w * s1; }
            float* o = MODP + (((size_t)kc * 2 + l) * 2) * 12288 + ng * 256 + lane * 4; *(f32x4*)o = acc0; *(f32x4*)(o + 12288) = acc1; }
        for (int i4 = gt; i4 < 2 * 32 * 2 * 256 * 4; i4 += NGT) { const int pq = i4 & 3, i = i4 >> 2; const int cp = i & 15, c = (i >> 4) & 15, d = (i >> 8) & 1, g = (i >> 9) & 31, l = i >> 14;
            float accv[32];
#pragma unroll
            for (int t = 0; t < 32; ++t) accv[t] = 0.f;
            const float step = __expf(KA(s5_log_step)[(l * 2 + d) * 32 + g]);
            float plre[16], plim[16], pbre[16], pbim[16], pcre[16], pcim[16];
#pragma unroll
            for (int q = 0; q < 16; ++q) { const int p = pq * 16 + q;
                plre[q] = KA(s5_a_re)[((l * 2 + d) * 32 + g) * 64 + p]; plim[q] = KA(s5_a_im)[((l * 2 + d) * 32 + g) * 64 + p];
                pbre[q] = KA(s5_b_re)[((l * 32 + g) * 64 + p) * 16 + cp]; pbim[q] = KA(s5_b_im)[((l * 32 + g) * 64 + p) * 16 + cp];
                pcre[q] = KA(s5_c_re)[((l * 32 + g) * 16 + c) * 64 + p]; pcim[q] = KA(s5_c_im)[((l * 32 + g) * 16 + c) * 64 + p]; }
#pragma unroll
            for (int q = 0; q < 16; ++q) {
                const float lre = plre[q], lim = plim[q];
                const float mag = __expf(lre * step); float sn, cs; sincos_ang(lim * step, sn, cs);
                const float are = mag * cs, aim = mag * sn, den = lre * lre + lim * lim, nre = are - 1.f;
                const float fre = (nre * lre + aim * lim) / den, fim = (aim * lre - nre * lim) / den;
                const float bre = pbre[q], bim = pbim[q], cre = pcre[q], cim = pcim[q];
                float tre = fre * bre - fim * bim, tim = fre * bim + fim * bre;
                float qre = cre * tre - cim * tim, qim = cre * tim + cim * tre;
#pragma unroll
                for (int t = 0; t < 32; ++t) { accv[t] += qre; const float nr = qre * are - qim * aim, ni = qre * aim + qim * are; qre = nr; qim = ni; }
            }
            float* o = KTAB + ((((size_t)(l * 32 + g) * 2 + d) * 32) * 256) + c * 16 + cp;
#pragma unroll
            for (int t = 0; t < 32; ++t) { float v = accv[t]; v += __shfl_xor(v, 1); v += __shfl_xor(v, 2); if (pq == 0) o[t * 256] = v; }
        }
        for (int i = gt; i < 2 * 32 * 2 * 64 * 16; i += NGT) { const int cp = i & 15, p = (i >> 4) & 63, d = (i >> 10) & 1, g = (i >> 11) & 31, l = i >> 16;
            const float step = __expf(KA(s5_log_step)[(l * 2 + d) * 32 + g]);
            const float lre = KA(s5_a_re)[((l * 2 + d) * 32 + g) * 64 + p], lim = KA(s5_a_im)[((l * 2 + d) * 32 + g) * 64 + p];
            float sn, cs; sincos_ang(lim * step, sn, cs); const float mag = __expf(lre * step);
            const float are = mag * cs, aim = mag * sn, den = lre * lre + lim * lim, nre = are - 1.f;
            const float fre = (nre * lre + aim * lim) / den, fim = (aim * lre - nre * lim) / den;
            const float bre = KA(s5_b_re)[((l * 32 + g) * 64 + p) * 16 + cp], bim = KA(s5_b_im)[((l * 32 + g) * 64 + p) * 16 + cp];
            float vre = fre * bre - fim * bim, vim = fre * bim + fim * bre;
            bf16_t* o = WE + (((size_t)(l * 32 + g) * 256) + d * 128 + p) * 512 + cp;
            float pre = 1.f, pim = 0.f;
#pragma unroll 8
            for (int j = 0; j < 32; ++j) { const int sx = d == 0 ? 31 - j : j; o[sx * 16] = (bf16_t)f2bf(vre); o[(size_t)64 * 512 + sx * 16] = (bf16_t)f2bf(vim);
                const float nr = vre * are - vim * aim, ni = vre * aim + vim * are; vre = nr; vim = ni;
                const float qr = pre * are - pim * aim, qi = pre * aim + pim * are; pre = qr; pim = qi; }
            if (cp == 0) { APOW[(((size_t)(l * 32 + g) * 2 + d) * 64 + p) * 2 + 0] = pre; APOW[(((size_t)(l * 32 + g) * 2 + d) * 64 + p) * 2 + 1] = pim; }
        }
        for (int i = gt; i < 2 * 32 * 2 * 16 * 64; i += NGT) { const int p = i & 63, c = (i >> 6) & 15, d = (i >> 10) & 1, g = (i >> 11) & 31, l = i >> 16;
            const float step = __expf(KA(s5_log_step)[(l * 2 + d) * 32 + g]);
            const float lre = KA(s5_a_re)[((l * 2 + d) * 32 + g) * 64 + p], lim = KA(s5_a_im)[((l * 2 + d) * 32 + g) * 64 + p];
            float sn, cs; sincos_ang(lim * step, sn, cs); const float mag = __expf(lre * step);
            const float are = mag * cs, aim = mag * sn;
            const float cre = KA(s5_c_re)[((l * 32 + g) * 16 + c) * 64 + p], cim = KA(s5_c_im)[((l * 32 + g) * 16 + c) * 64 + p];
            float gre = cre * are - cim * aim, gim = cre * aim + cim * are;
            bf16_t* o = WTC + (((size_t)(l * 32 + g) * 512) + c) * 768 + 512 + d * 128 + p;
#pragma unroll 8
            for (int m = 1; m <= 32; ++m) { const int t = d == 0 ? m - 1 : 32 - m; o[(size_t)t * 16 * 768] = (bf16_t)f2bf(gre); o[(size_t)t * 16 * 768 + 64] = (bf16_t)f2bf(-gim);
                const float nr = gre * are - gim * aim, ni = gre * aim + gim * are; gre = nr; gim = ni; }
        }
            }
        __syncthreads();
        {
            constexpr int T_GU = (PGA_J0 / 4) * 32 * 8, T_DN = 0, T_IN = 2 * 32 * 22, T_OUT = 2 * 32 * 8, T_GLU = 2 * 8 * 2, NIT = T_GU + T_DN + T_IN + T_GLU;
            f32x4 cur[8], nxt[8];
            const float* src; bf16_t* dst; int Kd, Nd;
#define CV_DECODE(it, srcp, dstp, Kv, Nv) do { int r_ = (it); \
                if (r_ < T_GU) { const int b_ = r_ >> 8, q_ = r_ & 255; Kv = 2048; Nv = 2048; srcp = KA(w_gate_up) + (size_t)b_ * 2048 * 2048 + (size_t)(q_ >> 3) * 64 * 2048 + (q_ & 7) * 256; dstp = WGU + (size_t)b_ * 2048 * 2048 + (size_t)(q_ & 7) * 256 * 2048 + (q_ >> 3) * 64; } \
                else if ((r_ -= T_GU) < T_DN) { const int b_ = r_ >> 7, q_ = r_ & 127; Kv = 1024; Nv = 2048; srcp = KA(w_down) + (size_t)b_ * 1024 * 2048 + (size_t)(q_ >> 3) * 64 * 2048 + (q_ & 7) * 256; dstp = WDN + (size_t)b_ * 2048 * 1024 + (size_t)(q_ & 7) * 256 * 1024 + (q_ >> 3) * 64; } \
                else if ((r_ -= T_DN) < T_IN) { const int b_ = r_ / 704, q_ = r_ % 704; Kv = 2048; Nv = INC; srcp = KA(w_in) + (size_t)b_ * D * INC + (size_t)(q_ / 22) * 64 * INC + (q_ % 22) * 256; dstp = WIN + (size_t)b_ * INC * D + (size_t)(q_ % 22) * 256 * D + (q_ / 22) * 64; } \
                else if ((r_ -= T_IN) < 0) { } \
                else { const int b_ = r_ >> 4, q_ = r_ & 15; Kv = 512; Nv = 512; srcp = KA(s5_w_glu) + (size_t)b_ * 512 * 512 + (size_t)(q_ >> 1) * 64 * 512 + (q_ & 1) * 256; dstp = WGLU + (size_t)b_ * 512 * 512 + (size_t)(q_ & 1) * 256 * 512 + (q_ >> 1) * 64; } } while (0)
#define CV_LOAD(v, srcp, Nv) do { _Pragma("unroll") for (int j_ = 0; j_ < 4; ++j_) { v[2 * j_] = __builtin_nontemporal_load((const f32x4*)((srcp) + (size_t)(8 * wave + 2 * j_) * (Nv) + lane * 4)); v[2 * j_ + 1] = __builtin_nontemporal_load((const f32x4*)((srcp) + (size_t)(8 * wave + 2 * j_ + 1) * (Nv) + lane * 4)); } } while (0)
            LAS int* qw = (LAS int*)(lds + LDSCTL_OFF + 1024);
            unsigned* qctr = (unsigned*)(ws + WS_CTL) + CW_QB;
            if (tid == 0) { qw[0] = T_GU + T_DN + (int)atomicAdd(qctr, 1u); qw[1] = T_GU + T_DN + (int)atomicAdd(qctr, 1u); }
            __syncthreads();
            int it = qw[0], nit = qw[1];
            if (it < NIT) { CV_DECODE(it, src, dst, Kd, Nd); CV_LOAD(cur, src, Nd); }
            while (it < NIT) {
                const float* nsrc = src; bf16_t* ndst = dst; int nK = Kd, nN = Nd;
                if (nit < NIT) { CV_DECODE(nit, nsrc, ndst, nK, nN); CV_LOAD(nxt, nsrc, nN); }
                int qn = 0; if (tid == 0) qn = T_GU + T_DN + (int)atomicAdd(qctr, 1u);
#pragma unroll
                for (int j = 0; j < 4; ++j)
#pragma unroll
                    for (int e = 0; e < 4; ++e) *(LAS unsigned*)(lds + ((4 * lane + e) * 32 + ((4 * wave + j + lane) & 31)) * 4) = cvt_pk_bf16(cur[2 * j][e], cur[2 * j + 1][e]);
                __syncthreads();
#pragma unroll
                for (int q = 0; q < 4; ++q) { const int n = q * 64 + (tid >> 3), c = tid & 7; u32x4 w;
                    w.x = *(const LAS unsigned*)(lds + (n * 32 + ((4 * c + 0 + (n >> 2)) & 31)) * 4); w.y = *(const LAS unsigned*)(lds + (n * 32 + ((4 * c + 1 + (n >> 2)) & 31)) * 4);
                    w.z = *(const LAS unsigned*)(lds + (n * 32 + ((4 * c + 2 + (n >> 2)) & 31)) * 4); w.w = *(const LAS unsigned*)(lds + (n * 32 + ((4 * c + 3 + (n >> 2)) & 31)) * 4);
                    *(u32x4*)(dst + (size_t)n * Kd + c * 8) = w; }
                if (tid == 0) qw[2] = qn;
                __syncthreads();
#pragma unroll
                for (int j = 0; j < 8; ++j) cur[j] = nxt[j];
                src = nsrc; dst = ndst; Kd = nK; Nd = nN; it = nit; nit = qw[2];
            }
            __syncthreads();
            {
                constexpr int NIT8 = T_GU + T_DN + T_OUT;
#define CV8_DECODE(it8, srcp, dstp, Kv) do { int r_ = (it8); \
                    if (r_ < T_GU) { const int b_ = r_ >> 8, q_ = r_ & 255; Kv = 2048; srcp = KA(w_gate_up) + (size_t)b_ * 2048 * 2048 + (size_t)(q_ >> 3) * 64 * 2048 + (q_ & 7) * 256; dstp = (unsigned char*)WGU + (size_t)b_ * 2048 * 2048 + (size_t)(q_ & 7) * 256 * 2048 + (q_ >> 3) * 64; } \
                    else { r_ -= T_GU + T_DN; const int b_ = r_ >> 8, q_ = r_ & 255, kt_ = q_ >> 3, kn_ = kt_ < 8 ? kt_ : (kt_ < 16 ? kt_ + 16 : kt_ - 8); Kv = 2048; srcp = KA(w_out) + (size_t)b_ * D * D + (size_t)kt_ * 64 * 2048 + (q_ & 7) * 256; dstp = (unsigned char*)WOUT + (size_t)b_ * D * D + (size_t)(q_ & 7) * 256 * 2048 + kn_ * 64; } } while (0)
#define CV8_LOAD(v, srcp) do { _Pragma("unroll") for (int j_ = 0; j_ < 8; ++j_) v[j_] = __builtin_nontemporal_load((const f32x4*)((srcp) + (size_t)(8 * wave + j_) * 2048 + lane * 4)); } while (0)
                const float* src8; unsigned char* dst8; int K8;
                unsigned* qctr8 = (unsigned*)(ws + WS_CTL) + CW_Q8;
                if (tid == 0) { qw[0] = (int)atomicAdd(qctr8, 1u); qw[1] = (int)atomicAdd(qctr8, 1u); }
                __syncthreads();
                int it8 = qw[0], nit8 = qw[1];
                if (it8 < NIT8) { CV8_DECODE(it8, src8, dst8, K8); CV8_LOAD(cur, src8); }
                while (it8 < NIT8) {
                    const float* nsrc = src8; unsigned char* ndst = dst8; int nK = K8;
                    if (nit8 < NIT8) { CV8_DECODE(nit8, nsrc, ndst, nK); CV8_LOAD(nxt, nsrc); }
                    int qn = 0; if (tid == 0) qn = (int)atomicAdd(qctr8, 1u);
#pragma unroll
                    for (int j = 0; j < 2; ++j)
#pragma unroll
                        for (int e = 0; e < 4; ++e) *(LAS unsigned*)(lds + ((4 * lane + e) * 16 + ((2 * wave + j + lane) & 15)) * 4) =
                            pk4_fp8(cur[4 * j][e] * W8_SCALE, cur[4 * j + 1][e] * W8_SCALE, cur[4 * j + 2][e] * W8_SCALE, cur[4 * j + 3][e] * W8_SCALE);
                    __syncthreads();
#pragma unroll
                    for (int q = 0; q < 2; ++q) { const int id = q * 512 + tid, n = id >> 2, c = id & 3; u32x4 w;
                        w.x = *(const LAS unsigned*)(lds + (n * 16 + ((4 * c + 0 + (n >> 2)) & 15)) * 4); w.y = *(const LAS unsigned*)(lds + (n * 16 + ((4 * c + 1 + (n >> 2)) & 15)) * 4);
                        w.z = *(const LAS unsigned*)(lds + (n * 16 + ((4 * c + 2 + (n >> 2)) & 15)) * 4); w.w = *(const LAS unsigned*)(lds + (n * 16 + ((4 * c + 3 + (n >> 2)) & 15)) * 4);
                        *(u32x4*)(dst8 + (size_t)n * K8 + c * 16) = w; }
                    if (tid == 0) qw[2] = qn;
                    __syncthreads();
#pragma unroll
                    for (int j = 0; j < 8; ++j) cur[j] = nxt[j];
                    src8 = nsrc; dst8 = ndst; K8 = nK; it8 = nit8; nit8 = qw[2];
                }
#undef CV8_DECODE
#undef CV8_LOAD
            }
#undef CV_DECODE
#undef CV_LOAD
        }
    }
    SEAM(0);
    if (PHEN(1) && IN(1)) { PHASE_IDS
        for (int i = gt; i < 2 * 2 * 12288; i += NGT) { const int l = i / 24576, n = i % 12288; float s = KA(b_mod)[l * 12288 + n];
            for (int kc = 0; kc < 32; ++kc) s += MODP[(size_t)kc * 2 * 2 * 12288 + i]; MOD[i] = s; }
        for (int i = gt; i < 2 * 32 * 512 * 64; i += NGT) { const int k8 = i & 63, n = (i >> 6) & 511, g = (i >> 15) & 31, l = i >> 20;
            const int t = n >> 4, c = n & 15, s = k8 >> 1, cp0 = (k8 & 1) * 8; float v[8];
#pragma unroll
            for (int e = 0; e < 8; ++e) v[e] = 0.f;
            const float* kt = KTAB + ((size_t)(l * 32 + g) * 2) * 32 * 256;
            if (s <= t) { const float* p = kt + (0 * 32 + (t - s)) * 256 + c * 16 + cp0; const f32x4 a0 = *(const f32x4*)p, a1 = *(const f32x4*)(p + 4);
#pragma unroll
                for (int e = 0; e < 4; ++e) { v[e] += a0[e]; v[4 + e] += a1[e]; } }
            if (s >= t) { const float* p = kt + (1 * 32 + (s - t)) * 256 + c * 16 + cp0; const f32x4 a0 = *(const f32x4*)p, a1 = *(const f32x4*)(p + 4);
#pragma unroll
                for (int e = 0; e < 4; ++e) { v[e] += a0[e]; v[4 + e] += a1[e]; } }
            if (s == t) { const float dd = KA(s5_d)[l * 512 + g * 16 + c];
#pragma unroll
                for (int e = 0; e < 8; ++e) v[e] += (cp0 + e == c) ? dd : 0.f; }
            u32x4 w; w.x = cvt_pk_bf16(v[0], v[1]); w.y = cvt_pk_bf16(v[2], v[3]); w.z = cvt_pk_bf16(v[4], v[5]); w.w = cvt_pk_bf16(v[6], v[7]);
            *(u32x4*)(WTC + (((size_t)(l * 32 + g) * 512) + n) * 768 + k8 * 8) = w; }
    }
    SEAM(1);
    if (PHEN(2) && IN(2)) { PHASE_IDS
        for (int r = gw; r < ROWS; r += NGW) {
            const float* xr = (r < CTXL) ? KA(ctx) + (size_t)r * D : KA(x) + (size_t)(r - CTXL) * D; const float* md = MOD + (r < CTXL ? 12288 : 0);
            f32x4 v[8], sh[8], sc[8]; float ss = 0.f;
#pragma unroll
            for (int j = 0; j < 8; ++j) v[j] = *(const f32x4*)(xr + lane * 4 + 256 * j);
#pragma unroll
            for (int j = 0; j < 8; ++j) { const int c = lane * 4 + 256 * j; sh[j] = *(const f32x4*)(md + c); sc[j] = *(const f32x4*)(md + 2048 + c); }
#pragma unroll
            for (int j = 0; j < 8; ++j) ss += v[j][0] * v[j][0] + v[j][1] * v[j][1] + v[j][2] * v[j][2] + v[j][3] * v[j][3];
            const float rstd = __builtin_amdgcn_rsqf(wave_sum(ss) * (1.f / D) + EPS);
#pragma unroll
            for (int j = 0; j < 8; ++j) { const int c = lane * 4 + 256 * j;
                const f32x4 o = v[j] * rstd * (sc[j] + 1.f) + sh[j]; u32x2 w; w.x = cvt_pk_bf16(o[0], o[1]); w.y = cvt_pk_bf16(o[2], o[3]); *(u32x2*)(XN + (size_t)r * D + c) = w; }
        }
    }
    SEAM(2);

    for (int l = 0; l < NL; ++l) {
        const int pb = 3 + 10 * l;
        const float* MODL = MOD + (size_t)l * 2 * 12288;
        const float* xin_c = KA(ctx);
        const float* xin_l = KA(x) - (size_t)CTXL * D;
        const bf16_t* xin_b = (l == 0) ? (const bf16_t*)nullptr : (const bf16_t*)XB;
#define CNT ((unsigned*)(ws + WS_CTL) + CW_CNT + l * 2048)
        if (PHEN(3) && IN(pb + 0)) { PHASE_IDS
            pg8::DenseSched S; S.init(XN, D, ROWS / 256, WIN + (size_t)l * INC * D, D, INC / 256, G, bx);
            EpiInProj E{Z, UPX};
            pg8::gemm_phase<EpiInProj, pg8::DenseSched, false>(lds, D, D, D, S, E);
        }
        SEAM(pb + 0);
        if (PHEN(4) && IN(pb + 1)) { PHASE_IDS
            SUB(0) for (int r = gw; r < ROWS; r += NGW) {
                const int hs = lane >> 4, sub = lane & 15, half = sub >> 3, j0 = (sub & 7) * 4, d1 = half * 64 + j0;
#pragma unroll
                for (int part = 0; part < 2; ++part) {
                    const int hd = part == 0 ? hs : (hs & 1); const bool act = part == 0 || hs < 2;
                    bf16_t* zp = Z + (size_t)r * INC + (part == 0 ? ZC_AQ : ZC_AK) + hd * 128 + d1;
                    const s16x4 a1 = *(const s16x4*)zp, a2 = *(const s16x4*)(zp + 32);
                    float x1[4], x2[4], ss = 0.f;
#pragma unroll
                    for (int e = 0; e < 4; ++e) { x1[e] = bfs2f(a1[e]); x2[e] = bfs2f(a2[e]); ss += x1[e] * x1[e] + x2[e] * x2[e]; }
                    ss += __shfl_xor(ss, 1); ss += __shfl_xor(ss, 2); ss += __shfl_xor(ss, 4); ss += __shfl_xor(ss, 8);
                    const float rstd = __builtin_amdgcn_rsqf(ss * (1.f / 128.f) + EPS);
                    const float* nw = (part == 0 ? KA(q_norm_w) : KA(k_norm_w)) + l * 128 + d1;
                    const f32x4 w1 = *(const f32x4*)nw, w2 = *(const f32x4*)(nw + 32);
#pragma unroll
                    for (int e = 0; e < 4; ++e) { x1[e] = x1[e] * rstd * w1[e]; x2[e] = x2[e] * rstd * w2[e]; }
                    if (r >= CTXL) { const int t = r - CTXL; const float pos = (float)(half ? (t & 63) : (t >> 6));
#pragma unroll
                        for (int e = 0; e < 4; ++e) { const float freq = __builtin_amdgcn_exp2f(-(float)(j0 + e) * (LOG2_1E4 / 32.f)); float sn, cs; sincos_ang(pos * freq, sn, cs);
                            const float y1 = x1[e] * cs - x2[e] * sn, y2 = x1[e] * sn + x2[e] * cs; x1[e] = y1; x2[e] = y2; } }
                    if (act && !KA(rep)) { u32x2 w; w.x = cvt_pk_bf16(x1[0], x1[1]); w.y = cvt_pk_bf16(x1[2], x1[3]); *(u32x2*)zp = w; w.x = cvt_pk_bf16(x2[0], x2[1]); w.y = cvt_pk_bf16(x2[2], x2[3]); *(u32x2*)(zp + 32) = w; }
                }
            }
            SUB(1) for (int it = gt; it < ROWS * 64; it += NGT) { const int r = it >> 6, c = (it & 63) * 8; const bf16_t* zr = Z + (size_t)r * INC;
                const bool hasp = (r != 0 && r != CTXL), hasn = (r != CTXL - 1 && r != ROWS - 1);
                const bf16x8 bg = *(const bf16x8*)(zr + ZC_CB + c), c0 = *(const bf16x8*)(zr + ZC_CC + c), h0 = *(const bf16x8*)(zr + ZC_CH + c);
                bf16x8 cm = {}, hm = {}, cp_ = {}, hp = {};
                if (hasp) { cm = *(const bf16x8*)(zr - INC + ZC_CC + c); hm = *(const bf16x8*)(zr - INC + ZC_CH + c); }
                if (hasn) { cp_ = *(const bf16x8*)(zr + INC + ZC_CC + c); hp = *(const bf16x8*)(zr + INC + ZC_CH + c); }
                const float* cw = KA(conv_w) + (size_t)l * 3 * 512 + c; float o[8];
#pragma unroll
                for (int e = 0; e < 8; ++e) o[e] = bfs2f(bg[e]) * (cw[e] * bfs2f(cm[e]) * bfs2f(hm[e]) + cw[512 + e] * bfs2f(c0[e]) * bfs2f(h0[e]) + cw[1024 + e] * bfs2f(cp_[e]) * bfs2f(hp[e]));
                u32x2 w; w.x = pk4_fp8(o[0], o[1], o[2], o[3]); w.y = pk4_fp8(o[4], o[5], o[6], o[7]);
                *(u32x2*)((unsigned char*)MIX + (size_t)r * D + 1024 + c) = w; }
            asm volatile("s_waitcnt vmcnt(0)" ::: "memory"); __syncthreads();
            SUB(2) {
                pg8::BatchSched S; S.A = (const char*)UPX; S.B = (const char*)(WE + (size_t)l * 32 * 256 * 512); S.sA = (size_t)512 * 768 * 2; S.sB = (size_t)256 * 512 * 2; S.lda = 768; S.ldb = 512; S.nM = 2; S.nN = 1; S.nb = 32; S.G = G; S.c = bx;
                EpiS1 E{EB};
                pg8::gemm_phase<EpiS1, pg8::BatchSched, false>(lds, 768, 512, 512, S, E);
            }
            __syncthreads();
            SUB(3) for (int u = (G > 64 ? bx - 64 : bx); u >= 0 && u < NBLK * 4; u += (G > 64 ? G - 64 : G)) {
                const int b = u >> 2, h = u & 3, fr = lane & 15, fq = lane >> 4;
                LAS unsigned char* VT = lds; LAS unsigned char* KF = lds + 34816; LAS unsigned char* KBk = lds + 69632;
                const float l2gf = log2f(1.f - __builtin_amdgcn_exp2f(-5.f - (float)h)), l2gb = log2f(1.f - __builtin_amdgcn_exp2f(-5.f - (float)(3 - h)));
                {
                    const int j = tid >> 2, sub = tid & 3, row = b * 128 + j; const bf16_t* zr = Z + (size_t)row * INC;
                    const float wf = __builtin_amdgcn_exp2f(l2gf * (float)(127 - j)) * 0.08838834764831845f, wb = __builtin_amdgcn_exp2f(l2gb * (float)j) * 0.08838834764831845f;
                    const bool lat = row >= CTXL; const float tpos = (float)(row - CTXL);
#pragma unroll
                    for (int h8 = 0; h8 < 2; ++h8) { const int dk0 = 16 * sub + 8 * h8;
                        const bf16x8 k1 = *(const bf16x8*)(zr + ZC_RK + h * 128 + dk0), k2 = *(const bf16x8*)(zr + ZC_RK + h * 128 + 64 + dk0);
#pragma unroll
                        for (int e = 0; e < 8; ++e) { const int dk = dk0 + e; float y1 = bfs2f(k1[e]), y2 = bfs2f(k2[e]);
                            if (lat) { const float freq = __builtin_amdgcn_exp2f(-(float)dk * (LOG2_1E4 / 64.f)); float sn, cs; sincos_ang(tpos * freq, sn, cs); const float t1 = y1 * cs - y2 * sn, t2 = y1 * sn + y2 * cs; y1 = t1; y2 = t2; }
                            *(LAS bf16_t*)(KF + dk * 272 + j * 2) = (bf16_t)f2bf(y1 * wf); *(LAS bf16_t*)(KF + (dk + 64) * 272 + j * 2) = (bf16_t)f2bf(y2 * wf);
                            *(LAS bf16_t*)(KBk + dk * 272 + j * 2) = (bf16_t)f2bf(y1 * wb); *(LAS bf16_t*)(KBk + (dk + 64) * 272 + j * 2) = (bf16_t)f2bf(y2 * wb); } }
#pragma unroll
                    for (int q = 0; q < 4; ++q) { const bf16x8 v = *(const bf16x8*)(zr + ZC_RV + h * 128 + 32 * sub + 8 * q);
#pragma unroll
                        for (int e = 0; e < 8; ++e) *(LAS bf16_t*)(VT + (32 * sub + 8 * q + e) * 272 + j * 2) = (bf16_t)v[e]; }
                }
                __syncthreads();
                f32x4 af[8], ab[8];
#pragma unroll
                for (int n = 0; n < 8; ++n) { af[n] = (f32x4){0.f, 0.f, 0.f, 0.f}; ab[n] = (f32x4){0.f, 0.f, 0.f, 0.f}; }
#pragma unroll
                for (int k0 = 0; k0 < 128; k0 += 32) { const bf16x8 av = *(const LAS bf16x8*)(VT + (16 * wave + fr) * 272 + (k0 + fq * 8) * 2);
#pragma unroll
                    for (int n = 0; n < 8; ++n) { const bf16x8 bfv = *(const LAS bf16x8*)(KF + (16 * n + fr) * 272 + (k0 + fq * 8) * 2), bbv = *(const LAS bf16x8*)(KBk + (16 * n + fr) * 272 + (k0 + fq * 8) * 2);
                        af[n] = MFMA16(bfv, av, af[n]); ab[n] = MFMA16(bbv, av, ab[n]); } }
                float* of = KVT + ((size_t)(b * 4 + h) * 2) * 16384 + (16 * wave + fr) * 128 + 4 * fq;
#pragma unroll
                for (int n = 0; n < 8; ++n) { *(f32x4*)(of + 16 * n) = af[n]; *(f32x4*)(of + 16384 + 16 * n) = ab[n]; }
                __syncthreads();
            }
        }
        SEAM(pb + 1);
        if (PHEN(5) && IN(pb + 2)) { PHASE_IDS
            for (int idx = gt; idx < 8 * 16384; idx += NGT) { const int hd = idx >> 14, e = idx & 16383, h = hd >> 1, d = hd & 1;
                const float gam = 1.f - __builtin_amdgcn_exp2f(-5.f - (float)(d ? 3 - h : h)); const float g128 = __builtin_amdgcn_exp2f(128.f * log2f(gam)); float st = 0.f;
                for (int s0 = 0; s0 < NBLK; s0 += 33) { float kv[33];
#pragma unroll
                    for (int q = 0; q < 33; ++q) { const int s = s0 + q; const int b = d == 0 ? s : (s < 2 ? 1 - s : 67 - s); kv[q] = KVT[((size_t)(b * 4 + h) * 2 + d) * 16384 + e]; }
#pragma unroll
                    for (int q = 0; q < 33; ++q) { const int s = s0 + q; const int b = d == 0 ? s : (s < 2 ? 1 - s : 67 - s); SPREV[((size_t)(b * 4 + h) * 2 + d) * 16384 + e] = (bf16_t)f2bf(st); st = st * g128 + kv[q]; } } }
            for (int gd = G - 1 - bx; gd < 64; gd += G) { const int g = gd >> 1, d = gd & 1, seg = tid >> 6, p = tid & 63;
                const float are = APOW[(((size_t)(l * 32 + g) * 2 + d) * 64 + p) * 2 + 0], aim = APOW[(((size_t)(l * 32 + g) * 2 + d) * 64 + p) * 2 + 1];
                const float* Eg = EB + (size_t)g * 512 * 256 + d * 128 + p; bf16_t* Xg = UPX + (size_t)g * 512 * 768 + 512 + d * 128 + p;
                LAS float* ex = (LAS float*)lds;
                float er[33], ei[33];
#pragma unroll
                for (int q = 0; q < 33; ++q) { const int s_ = seg * 33 + q; const int j = d == 0 ? s_ : (s_ < 8 ? 7 - s_ : 271 - s_); er[q] = Eg[(size_t)j * 256]; ei[q] = Eg[(size_t)j * 256 + 64]; }
                float sre = 0.f, sim = 0.f;
#pragma unroll
                for (int q = 0; q < 33; ++q) { const float e_r = er[q], e_i = ei[q]; er[q] = sre; ei[q] = sim; const float nr = are * sre - aim * sim + e_r, ni = are * sim + aim * sre + e_i; sre = nr; sim = ni; }
                ex[(seg * 64 + p) * 2] = sre; ex[(seg * 64 + p) * 2 + 1] = sim;
                float pr = 1.f, pi = 0.f;
#pragma unroll
                for (int q = 0; q < 33; ++q) { const float nr = pr * are - pi * aim, ni = pr * aim + pi * are; pr = nr; pi = ni; }
                __syncthreads();
                float cre = 0.f, cim = 0.f;
                for (int s2 = 0; s2 < seg; ++s2) { const float e_r = ex[(s2 * 64 + p) * 2], e_i = ex[(s2 * 64 + p) * 2 + 1]; const float nr = pr * cre - pi * cim + e_r, ni = pr * cim + pi * cre + e_i; cre = nr; cim = ni; }
#pragma unroll
                for (int q = 0; q < 33; ++q) { const int s_ = seg * 33 + q; const int j = d == 0 ? s_ : (s_ < 8 ? 7 - s_ : 271 - s_);
                    Xg[(size_t)j * 768] = (bf16_t)f2bf(er[q] + cre); Xg[(size_t)j * 768 + 64] = (bf16_t)f2bf(ei[q] + cim);
                    const float nr = are * cre - aim * cim, ni = are * cim + aim * cre; cre = nr; cim = ni; }
                __syncthreads();
            }
            __syncthreads();
            for (int u = bx; u < 256 + (l == 0 ? 4 : 0); u += G) {
                if (u < 256) { const int half = u & 1, h = (u >> 1) & 3, qb = u >> 3; const int r0 = CTXL + qb * 256, k0 = half * (ROWS / 2);
                    unsigned* pcur = (unsigned*)(ws + WS_CTL) + CW_PG + bx; const int c0 = (int)__builtin_amdgcn_readfirstlane((int)__hip_atomic_load(pcur, __ATOMIC_RELAXED, __HIP_MEMORY_SCOPE_AGENT));
                    const PgA PG{KA(w_gate_up), KA(w_down), (unsigned char*)WGU, (unsigned char*)WDN, bx, c0};
                    att::attn_dense_body<true>(Z + (size_t)r0 * INC + ZC_AQ + h * 128, Z + (size_t)k0 * INC + ZC_AK + (h >> 1) * 128, Z + (size_t)k0 * INC + ZC_AV + (h >> 1) * 128,
                                         OP + ((size_t)half * ROWS + r0) * 512 + h * 128, ML + (((size_t)half * ROWS + r0) * 4 + h) * 2, ROWS / 2, (char*)lds_raw, PG);
                    if (tid == 0) { const int nc = c0 + 4 * PGA_NI; __hip_atomic_store(pcur, (unsigned)(nc > PGA_IPB ? PGA_IPB : nc), __ATOMIC_RELAXED, __HIP_MEMORY_SCOPE_AGENT); } }
                else { const int h = u - 256;
                    att::attn_dense_body<false>(Z + ZC_AQ + h * 128, Z + ZC_AK + (h >> 1) * 128, Z + ZC_AV + (h >> 1) * 128, OP + h * 128, ML + h * 2, CTXL, (char*)lds_raw); }
            }
        }
        SEAM(pb + 2);
        if (PHEN(6) && IN(pb + 3)) { PHASE_IDS
            SUB(4) for (int it = gt; it < ROWS * 4 * 32; it += NGT) { const int q4 = it & 31, h = (it >> 5) & 3, r = it >> 7; if (l == 1 && r < CTXL) continue;
                const float C = att::SCALE * 1.4426950408889634f;
                const f32x4 o0 = *(const f32x4*)(OP + (size_t)r * 512 + h * 128 + q4 * 4); f32x4 o = o0;
                if (r >= CTXL) { const float m0 = ML[((size_t)r * 4 + h) * 2], l0 = ML[((size_t)r * 4 + h) * 2 + 1], m1 = ML[(((size_t)ROWS + r) * 4 + h) * 2], l1 = ML[(((size_t)ROWS + r) * 4 + h) * 2 + 1];
                    const f32x4 o1 = *(const f32x4*)(OP + ((size_t)ROWS + r) * 512 + h * 128 + q4 * 4); const float mm = fmaxf(m0, m1);
                    const float w0 = l0 * __builtin_amdgcn_exp2f((m0 - mm) * C), w1 = l1 * __builtin_amdgcn_exp2f((m1 - mm) * C); const float inv = __builtin_amdgcn_rcpf(w0 + w1); o = (o0 * w0 + o1 * w1) * inv; }
                *(unsigned*)((unsigned char*)MIX + (size_t)r * D + 512 + h * 128 + q4 * 4) = pk4_fp8(o[0], o[1], o[2], o[3]); }
            asm volatile("s_waitcnt vmcnt(0)" ::: "memory"); __syncthreads();
            SUB(5) {
                pg8::BatchSched S; S.A = (const char*)UPX; S.B = (const char*)(WTC + (size_t)l * 32 * 512 * 768); S.sA = (size_t)512 * 768 * 2; S.sB = (size_t)512 * 768 * 2; S.lda = 768; S.ldb = 768; S.nM = 2; S.nN = 2; S.nb = 32; S.G = G; S.c = bx;
                EpiS3 E{YG};
                pg8::gemm_phase<EpiS3, pg8::BatchSched, false>(lds, 768, 768, 768, S, E);
            }
            __syncthreads();
            if (bx >= G / 2) { const int nup = G - G / 2, j = bx - G / 2, nreg = (l == 0) ? (nup >= 8 ? nup - 8 : 0) : nup;
                if (j < nreg) ret_out_unit(lds, ws, (8 + j) >> 2, (8 + j) & 3);
                else if (l == 0) for (int u = j - nreg; u < 8; u += nup) ret_out_unit(lds, ws, u >> 2, u & 3); }
        }
        SEAM(pb + 3);
        if (PHEN(7) && IN(pb + 4)) { PHASE_IDS
            {
                pg8::DenseSched S; S.init(YG, 512, ROWS / 256, WGLU + (size_t)l * 512 * 512, 512, 2, G, bx);
                EpiGLU E{YG, (unsigned char*)MIX, KA(s5_b_glu) + l * 512};
                pg8::gemm_phase<EpiGLU, pg8::DenseSched, false>(lds, 512, 512, 512, S, E);
            }
            int r3_off = 66;
            if (l == 0) {
                pg8::DenseSched S; S.init(MIX, D / 2, 1, (const unsigned char*)WOUT + (size_t)l * D * D, D / 2, D / 256, G, (bx + G - 66) % G);
                EpiOut E{xin_c, xin_l, xin_b, XA, MODL, 0, 0};
                pg8::gemm_phase<EpiOut, pg8::DenseSched, false, true>(lds, D / 2, D / 2, 768, S, E);
                r3_off = 74;
            }
            __syncthreads();
            { const int nup = G - G / 2, nreg = (l == 0) ? (nup >= 8 ? nup - 8 : 0) : nup;
                for (int u = 8 + nreg + (bx + G - (r3_off % G)) % G; u < NBLK * 4; u += G) ret_out_unit(lds, ws, u >> 2, u & 3); }
                }
        SEAM(pb + 4);
        if (PHEN(8) && IN(pb + 5)) { PHASE_IDS
            {
                pg8::DenseSched S; S.init((const unsigned char*)MIX + (size_t)CTXL * D, D / 2, SEQ / 256, (const unsigned char*)WOUT + (size_t)l * D * D, D / 2, D / 256, G, bx);
                EpiOut E{xin_c, xin_l, xin_b, XA, MODL, CTXL, 0};
                pg8::gemm_phase<EpiOut, pg8::DenseSched, false, true>(lds, D / 2, D / 2, D / 2, S, E);
            }
            if (l == 0) {
                pg8::DenseSched S; S.init((const unsigned char*)MIX + 1536, D / 2, 1, (const unsigned char*)WOUT + (size_t)l * D * D + 1536, D / 2, D / 256, G, bx);
                EpiOut E{xin_c, xin_l, xin_b, XA, MODL, 0, 1};
                pg8::gemm_phase<EpiOut, pg8::DenseSched, false, true>(lds, D / 2, D / 2, 256, S, E);
            }
        }
        SEAM(pb + 5);
        if (PHEN(9) && IN(pb + 6)) { PHASE_IDS
            if (l == NL - 1) {
                unsigned* pcur = (unsigned*)(ws + WS_CTL) + CW_PG + bx; const int c0 = (int)__builtin_amdgcn_readfirstlane((int)__hip_atomic_load(pcur, __ATOMIC_RELAXED, __HIP_MEMORY_SCOPE_AGENT));
                const PgA PG{KA(w_gate_up), KA(w_down), (unsigned char*)WGU, (unsigned char*)WDN, bx, c0};
                const int nst = (PGA_IPB - c0 + 3) / 4;
                for (int st = 0; st < nst + 2; ++st) { pga_rb(PG, lds, st, nst, wave); asm volatile("s_waitcnt vmcnt(0) lgkmcnt(0)" ::: "memory"); __syncthreads();
                    pga_ci(PG, lds, st, nst, wave); asm volatile("s_waitcnt vmcnt(0) lgkmcnt(0)" ::: "memory"); __syncthreads(); }
            }
            const int rbeg = (l == NL - 1) ? CTXL : 0; const int npair = (ROWS - rbeg) / 32; const int fr = lane & 15, fq = lane >> 4;
            constexpr int RS = 4112;
            LAS unsigned char* XS = lds; LAS unsigned char* XL = lds + 16 * RS;
            LAS float* lgp = (LAS float*)(lds + 32 * RS);
            {
#pragma unroll 1
              for (int task = bx; task < 2 * npair; task += G) {
                const int rb = rbeg + task * 16;
#pragma unroll
                for (int i = 0; i < 8; ++i) { const int rr_ = 2 * wave + (i >> 2), q = i & 3;
                    __builtin_amdgcn_global_load_lds((const unsigned*)(XA + (size_t)(rb + rr_) * D + q * 512 + lane * 8), (LAS unsigned*)(XS + rr_ * RS + q * 1024), 16, 0, 0); }
                const float* md = MODL + (rb < CTXL ? 12288 : 0) + 3 * 2048;
                f32x4 sh[4][2], sc[4][2];
#pragma unroll
                for (int i = 0; i < 4; ++i) { const int c = lane * 8 + 512 * i; sh[i][0] = *(const f32x4*)(md + c); sh[i][1] = *(const f32x4*)(md + c + 4); sc[i][0] = *(const f32x4*)(md + 2048 + c); sc[i][1] = *(const f32x4*)(md + 2048 + c + 4); }
                asm volatile("s_waitcnt vmcnt(0)" ::: "memory"); __syncthreads();
#pragma unroll
                for (int j = 0; j < 2; ++j) { const int rr_ = 2 * wave + j; bf16x8 xv[4]; float ss = 0.f;
#pragma unroll
                    for (int i = 0; i < 4; ++i) { xv[i] = *(const LAS bf16x8*)(XS + rr_ * RS + (lane * 8 + 512 * i) * 2);
#pragma unroll
                        for (int e = 0; e < 8; ++e) { const float f = bfs2f(xv[i][e]); ss += f * f; } }
                    const float rstd = __builtin_amdgcn_rsqf(wave_sum(ss) * (1.f / D) + EPS);
#pragma unroll
                    for (int i = 0; i < 4; ++i) { const int c = lane * 8 + 512 * i; const bf16x8 xq = xv[i];
                        const f32x4 v0 = {bfs2f(xq[0]), bfs2f(xq[1]), bfs2f(xq[2]), bfs2f(xq[3])}, v1 = {bfs2f(xq[4]), bfs2f(xq[5]), bfs2f(xq[6]), bfs2f(xq[7])};
                        const f32x4 f0 = v0 * rstd * (sc[i][0] + 1.f) + sh[i][0], f1 = v1 * rstd * (sc[i][1] + 1.f) + sh[i][1];
                        u32x4 hw; hw.x = cvt_pk_bf16(f0[0], f0[1]); hw.y = cvt_pk_bf16(f0[2], f0[3]); hw.z = cvt_pk_bf16(f1[0], f1[1]); hw.w = cvt_pk_bf16(f1[2], f1[3]);
                        { u32x2 f8; f8.x = pk4_fp8(f0[0], f0[1], f0[2], f0[3]); f8.y = pk4_fp8(f1[0], f1[1], f1[2], f1[3]); *(u32x2*)((unsigned char*)FB + (size_t)(rb + rr_) * D + c) = f8; }
                        u32x4 lw; lw.x = cvt_pk_bf16(f0[0] - bf2f(hw.x), f0[1] - bf2f(hw.x >> 16)); lw.y = cvt_pk_bf16(f0[2] - bf2f(hw.y), f0[3] - bf2f(hw.y >> 16));
                        lw.z = cvt_pk_bf16(f1[0] - bf2f(hw.z), f1[1] - bf2f(hw.z >> 16)); lw.w = cvt_pk_bf16(f1[2] - bf2f(hw.w), f1[3] - bf2f(hw.w >> 16));
                        *(LAS u32x4*)(XS + rr_ * RS + c * 2) = hw; *(LAS u32x4*)(XL + rr_ * RS + c * 2) = lw; } }
                __syncthreads();
                f32x4 acc0 = {0.f, 0.f, 0.f, 0.f}, acc1 = {0.f, 0.f, 0.f, 0.f};
                const bf16_t* wh = WRT + (((size_t)(l * 2 + 0) * 64 + wave * 8) * 32 + fr) * 32 + fq * 8; const bf16_t* wl = WRT + (((size_t)(l * 2 + 1) * 64 + wave * 8) * 32 + fr) * 32 + fq * 8;
                const LAS unsigned char* ahp = XS + fr * RS + (wave * 256 + fq * 8) * 2; const LAS unsigned char* alp = XL + fr * RS + (wave * 256 + fq * 8) * 2;
#pragma unroll
                for (int s = 0; s < 8; ++s) { const bf16x8 ah = *(const LAS bf16x8*)(ahp + s * 64), al = *(const LAS bf16x8*)(alp + s * 64);
                    const bf16x8 bh0 = *(const bf16x8*)(wh + 1024 * s), bh1 = *(const bf16x8*)(wh + 512 + 1024 * s), bl0 = *(const bf16x8*)(wl + 1024 * s), bl1 = *(const bf16x8*)(wl + 512 + 1024 * s);
                    acc0 = MFMA16(bh0, ah, acc0); acc0 = MFMA16(bh0, al, acc0); acc0 = MFMA16(bl0, ah, acc0);
                    acc1 = MFMA16(bh1, ah, acc1); acc1 = MFMA16(bh1, al, acc1); acc1 = MFMA16(bl1, ah, acc1); }
                LAS float* lgw = lgp + (wave * 16 + fr) * 32;
                *(LAS f32x4*)(lgw + 4 * fq) = acc0; *(LAS f32x4*)(lgw + 16 + 4 * fq) = acc1;
                __syncthreads();
                if (wave == 0 && !KA(rep)) { LAS float* lg = lgp; const float* br = KA(b_router) + l * 32;
                    float v[8]; const int e0 = 8 * fq;
#pragma unroll
                    for (int e = 0; e < 8; ++e) { const int idx = fr * 32 + e0 + e; v[e] = (((lg[idx] + lg[512 + idx]) + (lg[1024 + idx] + lg[1536 + idx])) + ((lg[2048 + idx] + lg[2560 + idx]) + (lg[3072 + idx] + lg[3584 + idx]))) + br[e0 + e]; }
                    float tv[4]; int te[4];
#pragma unroll
                    for (int k = 0; k < 4; ++k) { float best = v[0]; int be = 0;
#pragma unroll
                        for (int e = 1; e < 8; ++e) if (v[e] > best) { best = v[e]; be = e; }
                        be += e0;
#pragma unroll
                        for (int o = 16; o < 64; o <<= 1) { const float ob = __shfl_xor(best, o); const int oe = __shfl_xor(be, o); if (ob > best || (ob == best && oe < be)) { best = ob; be = oe; } }
                        tv[k] = best; te[k] = be;
#pragma unroll
                        for (int e = 0; e < 8; ++e) if (be == e0 + e) v[e] = -3.0e38f; }
                    const float e1 = __expf(tv[1] - tv[0]), e2 = __expf(tv[2] - tv[0]), e3 = __expf(tv[3] - tv[0]); const float inv = 1.f / (1.f + e1 + e2 + e3);
                    const int rr = rb + fr;
                    const int me = fq == 0 ? te[0] : (fq == 1 ? te[1] : (fq == 2 ? te[2] : te[3])); const float mg = fq == 0 ? inv : (fq == 1 ? e1 * inv : (fq == 2 ? e2 * inv : e3 * inv));
                    const unsigned rank = atomicAdd(CNT + me * 64, 1u); LIST[(size_t)me * ROWS + rank] = rr; TOKI[rr * 4 + fq] = (me << 16) | (int)rank; GATE[rr * 4 + fq] = mg;
                }
                __syncthreads();
              }
            }
        }
        SEAM(pb + 6);
        if (IN(pb + 7) || IN(pb + 8) || IN(pb + 9)) {
            LAS int* tb = (LAS int*)(lds + LDSCTL_OFF + LC_TB); LAS int* cn = (LAS int*)(lds + LDSCTL_OFF + LC_CNT); const int tid = opaque_tid();
            __syncthreads();
            if (tid < 32) cn[tid] = (int)__hip_atomic_load(CNT + tid * 64, __ATOMIC_RELAXED, __HIP_MEMORY_SCOPE_AGENT);
            __syncthreads();
            if (tid == 0) { int s = 0; for (int e = 0; e < 32; ++e) { tb[e] = s; s += (cn[e] + 255) >> 8; } tb[32] = s; }
            __syncthreads();
            { LAS unsigned char* te = (LAS unsigned char*)(lds + LDSCTL_OFF + LC_TE); const int nt_ = tb[32];
              for (int t_ = tid; t_ < nt_ && t_ < 192; t_ += 512) { int e = 0; for (int k = 1; k < 32; ++k) e += (tb[k] <= t_) ? 1 : 0; te[t_] = (unsigned char)e; } }
            __syncthreads();
        }
        if (PHEN(10) && IN(pb + 7)) { PHASE_IDS
            pg8::MoeSched S; S.tb = (const LAS int*)(lds + LDSCTL_OFF + LC_TB); S.cnt = (const LAS int*)(lds + LDSCTL_OFF + LC_CNT); S.A = (const char*)FB; S.B = (const char*)WGU + (size_t)l * 32 * 2048 * 2048;
            S.sB = (size_t)2048 * 2048; S.list = LIST; S.lda = D / 2; S.ldb = 1024; S.nN = 8; S.G = G; S.c = bx; S.gather = true;
            EpiGateUp E{(unsigned char*)HB, KA(b_gate_up) + (size_t)l * 32 * 2048};
            pg8::gemm_phase<EpiGateUp, pg8::MoeSched, true, true>(lds, D / 2, 1024, 1024, S, E);
        }
        SEAM(pb + 7);
        if (PHEN(11) && IN(pb + 8)) { PHASE_IDS
            pg8::MoeSched S; S.tb = (const LAS int*)(lds + LDSCTL_OFF + LC_TB); S.cnt = (const LAS int*)(lds + LDSCTL_OFF + LC_CNT); S.A = (const char*)HB; S.B = (const char*)WDN + (size_t)l * 32 * 2048 * 1024;
            S.sB = (size_t)2048 * 1024; S.list = LIST; S.lda = DE / 2; S.ldb = DE / 2; S.nN = 8; S.G = G; S.c = bx; S.gather = false;
            EpiDown E{YB, KA(b_down) + (size_t)l * 32 * 2048};
            pg8::gemm_phase<EpiDown, pg8::MoeSched, false, true>(lds, DE / 2, DE / 2, DE / 2, S, E);
        }
        SEAM(pb + 8);
        if (PHEN(12) && IN(pb + 9)) { PHASE_IDS
            const LAS int* tb = (const LAS int*)(lds + LDSCTL_OFF + LC_TB);
            const int rbeg = (l == NL - 1) ? CTXL : 0;
            for (int r0 = rbeg + gw; r0 < ROWS; r0 += 2 * NGW) {
                int rr[2]; rr[0] = r0; rr[1] = (r0 + NGW < ROWS) ? r0 + NGW : r0; const bool two = (r0 + NGW < ROWS);
                const bf16_t* yp[2][4]; float gk[2][4];
#pragma unroll
                for (int a_ = 0; a_ < 2; ++a_)
#pragma unroll
                    for (int k = 0; k < 4; ++k) { const int ti = TOKI[rr[a_] * 4 + k]; const int e = ti >> 16, rank = ti & 0xffff; yp[a_][k] = YB + ((size_t)tb[e] * 256 + rank) * D; gk[a_][k] = GATE[rr[a_] * 4 + k]; }
                f32x4 xo[2][4][2]; float ss[2] = {0.f, 0.f};
#pragma unroll
                for (int a_ = 0; a_ < 2; ++a_) { const bf16_t* x1 = XA + (size_t)rr[a_] * D; const float* g2 = MODL + (rr[a_] < CTXL ? 12288 : 0) + 5 * 2048;
#pragma unroll
                    for (int i = 0; i < 4; ++i) { const int c = lane * 8 + 512 * i; f32x4 s0 = {0.f, 0.f, 0.f, 0.f}, s1 = {0.f, 0.f, 0.f, 0.f};
#pragma unroll
                        for (int k = 0; k < 4; ++k) { const bf16x8 y = *(const bf16x8*)(yp[a_][k] + c);
                            s0 += (f32x4){bfs2f(y[0]), bfs2f(y[1]), bfs2f(y[2]), bfs2f(y[3])} * gk[a_][k]; s1 += (f32x4){bfs2f(y[4]), bfs2f(y[5]), bfs2f(y[6]), bfs2f(y[7])} * gk[a_][k]; }
                        { f32x4 xa0, xa1; ld8_bf16(x1 + c, xa0, xa1); xo[a_][i][0] = xa0 + *(const f32x4*)(g2 + c) * s0; xo[a_][i][1] = xa1 + *(const f32x4*)(g2 + c + 4) * s1; }
#pragma unroll
                        for (int q = 0; q < 4; ++q) ss[a_] += xo[a_][i][0][q] * xo[a_][i][0][q] + xo[a_][i][1][q] * xo[a_][i][1][q]; } }
#pragma unroll
                for (int a_ = 0; a_ < 2; ++a_) { if (a_ == 1 && !two) break; const int r = rr[a_];
                    if (l == NL - 1) {
#pragma unroll
                        for (int i = 0; i < 4; ++i) { const int c = lane * 8 + 512 * i; float* o = KA(out) + (size_t)(r - CTXL) * D + c; *(f32x4*)o = xo[a_][i][0]; *(f32x4*)(o + 4) = xo[a_][i][1]; }
                    } else {
                        const float rstd = __builtin_amdgcn_rsqf(wave_sum(ss[a_]) * (1.f / D) + EPS); const float* md = MOD + (size_t)(l + 1) * 2 * 12288 + (r < CTXL ? 12288 : 0);
                        f32x4 msc[4][2], msh[4][2];
#pragma unroll
                        for (int i = 0; i < 4; ++i) { const int c = lane * 8 + 512 * i; msc[i][0] = *(const f32x4*)(md + 2048 + c); msc[i][1] = *(const f32x4*)(md + 2048 + c + 4); msh[i][0] = *(const f32x4*)(md + c); msh[i][1] = *(const f32x4*)(md + c + 4); }
#pragma unroll
                        for (int i = 0; i < 4; ++i) { const int c = lane * 8 + 512 * i; st8_bf16(XB + (size_t)r * D + c, xo[a_][i][0], xo[a_][i][1]);
                            const f32x4 n0 = xo[a_][i][0] * rstd * (msc[i][0] + 1.f) + msh[i][0], n1 = xo[a_][i][1] * rstd * (msc[i][1] + 1.f) + msh[i][1];
                            u32x4 w; w.x = cvt_pk_bf16(n0[0], n0[1]); w.y = cvt_pk_bf16(n0[2], n0[3]); w.z = cvt_pk_bf16(n1[0], n1[1]); w.w = cvt_pk_bf16(n1[2], n1[3]); *(u32x4*)(XN + (size_t)r * D + c) = w; }
                    } }
            }
        }
        SEAM(pb + 9);
    }
#undef IN
#undef SEAM
}

extern "C" void kernel_launch(void* const* d_in, const int* in_sizes, int n_in, void* d_out, int out_size, void* d_ws, size_t ws_size, hipStream_t stream) {
    static int grid = 0;
    if (grid == 0) {
        if (n_in != 27 || out_size != SEQ * D || ws_size < WS_END) { fprintf(stderr, "kernel_launch: unexpected shapes: n_in %d out %d ws %zu (need %zu)\n", n_in, out_size, ws_size, (size_t)WS_END); grid = -1; return; }
        int dev = 0, cus = 0, per_cu = 0;
        if (hipGetDevice(&dev) != hipSuccess || hipDeviceGetAttribute(&cus, hipDeviceAttributeMultiprocessorCount, dev) != hipSuccess) { grid = -1; return; }
        if (hipFuncSetAttribute((const void*)mega_fwd, hipFuncAttributeMaxDynamicSharedMemorySize, LDS_BYTES) != hipSuccess) { fprintf(stderr, "kernel_launch: hipFuncSetAttribute failed\n"); grid = -1; return; }
        if (hipOccupancyMaxActiveBlocksPerMultiprocessor(&per_cu, (const void*)mega_fwd, 512, LDS_BYTES) != hipSuccess || per_cu < 1) { fprintf(stderr, "kernel_launch: occupancy query reports %d blocks per CU\n", per_cu); }
        (void)hipGetLastError();
        grid = cus;
    }
    if (grid < 0) return;
    if (hipMemsetAsync((char*)d_ws + WS_CTL, 0, CTL_BYTES, stream) != hipSuccess) { fprintf(stderr, "kernel_launch: memset failed\n"); return; }
    Args a{};
    const float** fp = (const float**)&a.x;
    for (int i = 0; i < 27; ++i) fp[i] = (const float*)d_in[i];
    a.out = (float*)d_out; a.ws = (unsigned char*)d_ws;
#if MK_MULTI
#ifndef REPMASK
#define REPMASK 0
#endif
    for (int p = 0; p < NPH; ++p) { a.ph_lo = p; a.ph_hi = p + 1; a.rep = 0; hipLaunchKernelGGL(mega_fwd, dim3(grid), dim3(512), LDS_BYTES, stream, a);
        const int ty = p < 3 ? p : 3 + (p - 3) % 10;
        if ((REPMASK >> ty) & 1) { a.rep = 1; hipLaunchKernelGGL(mega_fwd, dim3(grid), dim3(512), LDS_BYTES, stream, a); } }
#else
    a.ph_lo = 0; a.ph_hi = NPH; hipLaunchKernelGGL(mega_fwd, dim3(grid), dim3(512), LDS_BYTES, stream, a);
#endif
    const hipError_t le = hipPeekAtLastError();
    if (le != hipSuccess) fprintf(stderr, "kernel_launch: launch failed: %s\n", hipGetErrorName(le));
}
```
